# Optimizing an MI355X kernel written in HIP

```python
import math, functools
import jax, jax.numpy as jnp
from jax import lax
import numpy as np

D_MODEL = 2048
BATCH = 2
SEQ = 4096
DEPTH = 1
DEC_BATCH = 8
DEC_SEQ = 8
PAST_LEN = 16384
PAGE_SIZE = 128

ATT_WIDTH = D_MODEL // 2
SSM_WIDTH = D_MODEL - ATT_WIDTH
HEAD_DIM = 128
N_ATT_HEADS = ATT_WIDTH // HEAD_DIM
SSM_GROUP = 16
N_SSM_GROUPS = SSM_WIDTH // SSM_GROUP
SSM_STATE = 64
D_FF = 4 * D_MODEL
Q_BLOCK = 128
ALPHA = (2 * DEPTH) ** 0.25
BETA = (8 * DEPTH) ** -0.25
LN_EPS = 1e-5
N_MOD = 6
IN_COLS = 3 * ATT_WIDTH + N_ATT_HEADS + SSM_WIDTH
SCALE = HEAD_DIM ** -0.5
FORGET_BIAS_LO = 2.0
FORGET_BIAS_HI = 10.0

kernel_name = "fox_s5_parallel_heads_deepnorm_adaln_step"


def _layer_norm(x, g=None, b=None):
    xf = x.astype(jnp.float32)
    mu = jnp.mean(xf, axis=-1, keepdims=True)
    var = jnp.mean(jnp.square(xf - mu), axis=-1, keepdims=True)
    y = (xf - mu) * lax.rsqrt(var + LN_EPS)
    if g is not None:
        y = y * g.astype(jnp.float32) + b.astype(jnp.float32)
    return y.astype(x.dtype)


def _attend_prompt(q, k, v, logf):
    bsz, s_len = q.shape[:2]
    n_blk = s_len // Q_BLOCK
    f_cum = jnp.transpose(lax.cumsum(logf, axis=1), (0, 2, 1))
    q_blk = jnp.transpose(q.reshape(bsz, n_blk, Q_BLOCK, N_ATT_HEADS, HEAD_DIM), (1, 0, 2, 3, 4))
    f_blk = jnp.transpose(f_cum.reshape(bsz, N_ATT_HEADS, n_blk, Q_BLOCK), (2, 0, 1, 3))
    k_pos = jnp.arange(s_len)

    def block(args):
        qi, fi, i = args
        s = (jnp.einsum('bqhd,bkhd->bhqk', qi, k).astype(jnp.float32) * SCALE
             + fi[..., :, None] - f_cum[:, :, None, :])
        q_pos = i * Q_BLOCK + jnp.arange(Q_BLOCK)
        s = jnp.where(k_pos[None, :] <= q_pos[:, None], s, -jnp.inf)
        p = jax.nn.softmax(s, axis=-1).astype(v.dtype)
        return jnp.einsum('bhqk,bkhd->bqhd', p, v)

    out = lax.map(block, (q_blk, f_blk, jnp.arange(n_blk)))
    return jnp.transpose(out, (1, 0, 2, 3, 4)).reshape(bsz, s_len, ATT_WIDTH)


def _attend_sample(q, k, v, logf, cache_k, cache_v, cache_logf, page_table):
    nb, n_q = q.shape[:2]
    k_past = cache_k[page_table].reshape(nb, -1, N_ATT_HEADS, HEAD_DIM)
    v_past = cache_v[page_table].reshape(nb, -1, N_ATT_HEADS, HEAD_DIM)
    lf_past = cache_logf[page_table].reshape(nb, -1, N_ATT_HEADS).astype(jnp.float32)
    past = k_past.shape[1]
    f_new = jnp.transpose(lax.cumsum(logf, axis=1), (0, 2, 1))
    decay_past = jnp.transpose(lax.cumsum(lf_past, axis=1, reverse=True) - lf_past, (0, 2, 1))
    s_past = (jnp.einsum('bqhd,bkhd->bhqk', q, k_past).astype(jnp.float32) * SCALE
              + decay_past[:, :, None, :] + f_new[:, :, :, None])
    s_new = (jnp.einsum('bqhd,bkhd->bhqk', q, k).astype(jnp.float32) * SCALE
             + f_new[:, :, :, None] - f_new[:, :, None, :])
    causal = jnp.arange(n_q)[None, :] <= jnp.arange(n_q)[:, None]
    s_new = jnp.where(causal, s_new, -jnp.inf)
    p = jax.nn.softmax(jnp.concatenate([s_past, s_new], axis=-1), axis=-1).astype(v.dtype)
    out = (jnp.einsum('bhqk,bkhd->bqhd', p[..., :past], v_past)
           + jnp.einsum('bhqk,bkhd->bqhd', p[..., past:], v))
    return out.reshape(nb, n_q, ATT_WIDTH)


def _s5(u, h0, a_re, a_im, log_dt, b_re, b_im, c_re, c_im, d_skip, w_glu, b_glu):
    f32 = jnp.float32
    bsz, l_len = u.shape[:2]
    u = u.astype(f32).reshape(bsz, l_len, N_SSM_GROUPS, SSM_GROUP)
    a_re, a_im = a_re.astype(f32), a_im.astype(f32)
    dt = jnp.exp(log_dt.astype(f32))[:, None]
    mag = jnp.exp(a_re * dt)
    lam_re, lam_im = mag * jnp.cos(a_im * dt), mag * jnp.sin(a_im * dt)
    den = jnp.square(a_re) + jnp.square(a_im)
    n_re = lam_re - 1.0
    k_re = (n_re * a_re + lam_im * a_im) / den
    k_im = (lam_im * a_re - n_re * a_im) / den
    b_re, b_im = b_re.astype(f32), b_im.astype(f32)
    bb_re = k_re[..., None] * b_re - k_im[..., None] * b_im
    bb_im = k_re[..., None] * b_im + k_im[..., None] * b_re
    bu_re = jnp.einsum('blgc,gpc->blgp', u, bb_re)
    bu_im = jnp.einsum('blgc,gpc->blgp', u, bb_im)
    ar = jnp.broadcast_to(lam_re, bu_re.shape)
    ai = jnp.broadcast_to(lam_im, bu_re.shape)

    def combine(e1, e2):
        a1r, a1i, b1r, b1i = e1
        a2r, a2i, b2r, b2i = e2
        return (a1r * a2r - a1i * a2i, a1r * a2i + a1i * a2r,
                a2r * b1r - a2i * b1i + b2r, a2r * b1i + a2i * b1r + b2i)

    _, _, h_re, h_im = lax.associative_scan(combine, (ar, ai, bu_re, bu_im), axis=1)
    if h0 is not None:
        h0_re, h0_im = h0[0].astype(f32)[:, None], h0[1].astype(f32)[:, None]
        steps = jnp.arange(1, l_len + 1, dtype=f32)[:, None, None]
        pm = jnp.exp(a_re * dt * steps)
        p_re, p_im = pm * jnp.cos(a_im * dt * steps), pm * jnp.sin(a_im * dt * steps)
        h_re = h_re + p_re * h0_re - p_im * h0_im
        h_im = h_im + p_re * h0_im + p_im * h0_re
    y = (jnp.einsum('gcp,blgp->blgc', c_re.astype(f32), h_re)
         - jnp.einsum('gcp,blgp->blgc', c_im.astype(f32), h_im)
         + d_skip.astype(f32) * u)
    z = jax.nn.gelu(y)
    zz = jnp.einsum('blgc,gce->blge', z, w_glu.astype(f32)) + b_glu.astype(f32)
    out = zz[..., :SSM_GROUP] * jax.nn.sigmoid(zz[..., SSM_GROUP:])
    return out.reshape(bsz, l_len, SSM_WIDTH), h_re[:, -1], h_im[:, -1]


def _trunk_layer(x, c, attend, h0, w_ada, b_ada, w_in, b_f, w_o, a_re, a_im, log_dt,
                 b_re, b_im, c_re, c_im, d_skip, w_glu, b_glu, ln1_g, ln1_b,
                 w_up, w_down, ln2_g, ln2_b):
    bsz, l_len, _ = x.shape
    mod = (jax.nn.silu(c) @ w_ada + b_ada).reshape(bsz, N_MOD, 1, D_MODEL)
    shift1, scale1, gate1, shift2, scale2, gate2 = (mod[:, i] for i in range(N_MOD))
    h = _layer_norm(x) * (1 + scale1) + shift1
    proj = h @ w_in
    cuts = [ATT_WIDTH, 2 * ATT_WIDTH, 3 * ATT_WIDTH, 3 * ATT_WIDTH + N_ATT_HEADS]
    q, k, v, f_logit, u = jnp.split(proj, cuts, axis=-1)
    q = q.reshape(bsz, l_len, N_ATT_HEADS, HEAD_DIM)
    k = k.reshape(bsz, l_len, N_ATT_HEADS, HEAD_DIM)
    v = v.reshape(bsz, l_len, N_ATT_HEADS, HEAD_DIM)
    logf = jax.nn.log_sigmoid(f_logit.astype(jnp.float32) + b_f.astype(jnp.float32))
    att = attend(q, k, v, logf)
    ssm, h_re, h_im = _s5(u, h0, a_re, a_im, log_dt, b_re, b_im, c_re, c_im, d_skip, w_glu, b_glu)
    mix = jnp.concatenate([att, ssm.astype(x.dtype)], axis=-1) @ w_o
    x = _layer_norm(ALPHA * x + (1 + gate1) * mix, ln1_g, ln1_b)
    h2 = _layer_norm(x) * (1 + scale2) + shift2
    m = jnp.square(jax.nn.relu(h2 @ w_up)) @ w_down
    x = _layer_norm(ALPHA * x + (1 + gate2) * m, ln2_g, ln2_b)
    return x, k, v, logf.astype(x.dtype), h_re, h_im


def setup_inputs(seed: int = 0) -> dict:
    key = jax.random.key(seed)
    ks = iter(jax.random.split(key, 40))
    nrm = lambda shape, s=1.0: jax.random.normal(next(ks), shape, jnp.float32) * s
    n_pages = PAST_LEN // PAGE_SIZE
    n_used = DEC_BATCH * n_pages
    n_pool = n_used + max(1, n_used // 4)
    page_table = jax.random.permutation(next(ks), n_pool)[:n_used].reshape(DEC_BATCH, n_pages).astype(jnp.int32)
    L = DEPTH
    head_bias = jnp.linspace(FORGET_BIAS_LO, FORGET_BIAS_HI, N_ATT_HEADS, dtype=jnp.float32)
    return {
        "x_prompt": nrm((BATCH, SEQ, D_MODEL)),
        "x_sample": nrm((DEC_BATCH, DEC_SEQ, D_MODEL)),
        "c_prompt": nrm((BATCH, D_MODEL)),
        "c_sample": nrm((DEC_BATCH, D_MODEL)),
        "cache_k": nrm((L, n_pool, PAGE_SIZE, N_ATT_HEADS, HEAD_DIM)),
        "cache_v": nrm((L, n_pool, PAGE_SIZE, N_ATT_HEADS, HEAD_DIM)),
        "cache_logf": jax.nn.log_sigmoid(head_bias + nrm((L, n_pool, PAGE_SIZE, N_ATT_HEADS), 0.5)),
        "state_ssm_re": nrm((L, DEC_BATCH, N_SSM_GROUPS, SSM_STATE), 0.1),
        "state_ssm_im": nrm((L, DEC_BATCH, N_SSM_GROUPS, SSM_STATE), 0.1),
        "page_table": page_table,
        "w_ada": nrm((L, D_MODEL, N_MOD * D_MODEL), 0.5 * D_MODEL ** -0.5),
        "b_ada": nrm((L, N_MOD * D_MODEL), 0.02),
        "w_in": nrm((L, D_MODEL, IN_COLS), D_MODEL ** -0.5),
        "b_f": head_bias + nrm((L, N_ATT_HEADS), 0.5),
        "w_o": nrm((L, D_MODEL, D_MODEL), BETA * D_MODEL ** -0.5),
        "a_re": -0.5 * jnp.exp(nrm((L, N_SSM_GROUPS, SSM_STATE), 0.05)),
        "a_im": jnp.pi * jnp.arange(SSM_STATE, dtype=jnp.float32) + nrm((L, N_SSM_GROUPS, SSM_STATE), 0.01),
        "log_dt": jax.random.uniform(next(ks), (L, N_SSM_GROUPS), jnp.float32, math.log(1e-3), math.log(1e-1)),
        "b_re": nrm((L, N_SSM_GROUPS, SSM_STATE, SSM_GROUP), (2 * SSM_GROUP) ** -0.5),
        "b_im": nrm((L, N_SSM_GROUPS, SSM_STATE, SSM_GROUP), (2 * SSM_GROUP) ** -0.5),
        "c_re": nrm((L, N_SSM_GROUPS, SSM_GROUP, SSM_STATE), (2 * SSM_STATE) ** -0.5),
        "c_im": nrm((L, N_SSM_GROUPS, SSM_GROUP, SSM_STATE), (2 * SSM_STATE) ** -0.5),
        "d_skip": nrm((L, N_SSM_GROUPS, SSM_GROUP)),
        "w_glu": nrm((L, N_SSM_GROUPS, SSM_GROUP, 2 * SSM_GROUP), SSM_GROUP ** -0.5),
        "b_glu": nrm((L, N_SSM_GROUPS, 2 * SSM_GROUP), 0.02),
        "ln1_g": 1.0 + nrm((L, D_MODEL), 0.02),
        "ln1_b": nrm((L, D_MODEL), 0.02),
        "w_up": nrm((L, D_MODEL, D_FF), D_MODEL ** -0.5),
        "w_down": nrm((L, D_FF, D_MODEL), BETA * D_FF ** -0.5),
        "ln2_g": 1.0 + nrm((L, D_MODEL), 0.02),
        "ln2_b": nrm((L, D_MODEL), 0.02),
    }


def reference(x_prompt, x_sample, c_prompt, c_sample, cache_k, cache_v, cache_logf,
              state_ssm_re, state_ssm_im, page_table, w_ada, b_ada, w_in, b_f, w_o,
              a_re, a_im, log_dt, b_re, b_im, c_re, c_im, d_skip, w_glu, b_glu,
              ln1_g, ln1_b, w_up, w_down, ln2_g, ln2_b):
    yp, ys = x_prompt, x_sample
    kp_l, vp_l, fp_l, hpr_l, hpi_l = [], [], [], [], []
    ks_l, vs_l, fs_l, hsr_l, hsi_l = [], [], [], [], []
    for l in range(DEPTH):
        weights = (w_ada[l], b_ada[l], w_in[l], b_f[l], w_o[l], a_re[l], a_im[l], log_dt[l],
                   b_re[l], b_im[l], c_re[l], c_im[l], d_skip[l], w_glu[l], b_glu[l],
                   ln1_g[l], ln1_b[l], w_up[l], w_down[l], ln2_g[l], ln2_b[l])
        yp, kp, vp, fp, hpr, hpi = _trunk_layer(yp, c_prompt, _attend_prompt, None, *weights)
        attend_s = functools.partial(_attend_sample, cache_k=cache_k[l], cache_v=cache_v[l],
                                     cache_logf=cache_logf[l], page_table=page_table)
        ys, kss, vss, fss, hsr, hsi = _trunk_layer(ys, c_sample, attend_s,
                                                   (state_ssm_re[l], state_ssm_im[l]), *weights)
        kp_l.append(kp); vp_l.append(vp); fp_l.append(fp); hpr_l.append(hpr); hpi_l.append(hpi)
        ks_l.append(kss); vs_l.append(vss); fs_l.append(fss); hsr_l.append(hsr); hsi_l.append(hsi)
    return (yp, ys,
            jnp.stack(kp_l), jnp.stack(vp_l), jnp.stack(fp_l), jnp.stack(hpr_l), jnp.stack(hpi_l),
            jnp.stack(ks_l), jnp.stack(vs_l), jnp.stack(fs_l), jnp.stack(hsr_l), jnp.stack(hsi_l))
```

```cpp
#include <hip/hip_runtime.h>
#include <cstdint>
#include <cstdio>
#include <cmath>

constexpr int D = 2048, NB = 2, SEQ = 4096, DB = 8, DS = 8, PAST = 16384, PAGE = 128, NPG = PAST / PAGE;
constexpr int AW = 1024, SW = 1024, HD = 128, NH = 8, SG = 16, NG = 64, SP = 64, DFF = 8192, NMOD = 6;
constexpr int INC = 3 * AW + NH + SW;
constexpr int MP = NB * SEQ, MS = DB * DS, M = MP + MS;
constexpr int NBT = NB + DB;
constexpr int N1 = 3 * AW + SW;
constexpr float ALPHA = 1.189207115002721f;
constexpr float LN_EPS = 1e-5f;
constexpr float SCALE = 0.08838834764831845f;
constexpr size_t O_YP = 0, O_YS = O_YP + (size_t)MP * D, O_KP = O_YS + (size_t)MS * D, O_VP = O_KP + (size_t)MP * AW,
                 O_LFP = O_VP + (size_t)MP * AW, O_SRP = O_LFP + (size_t)MP * NH, O_SIP = O_SRP + NB * NG * SP,
                 O_KS = O_SIP + NB * NG * SP, O_VS = O_KS + (size_t)MS * AW, O_LFS = O_VS + (size_t)MS * AW,
                 O_SRS = O_LFS + MS * NH, O_SIS = O_SRS + DB * NG * SP, O_END = O_SIS + DB * NG * SP;
constexpr size_t MiB = 1u << 20;
constexpr size_t WS_CTL = 0, CTL_ZERO_BYTES = 1 * MiB;
constexpr size_t WS_MOD = 1 * MiB;
constexpr size_t WS_W1T = 2 * MiB;
constexpr size_t WS_W2T = 18 * MiB;
constexpr size_t WS_W3T = 26 * MiB;
constexpr size_t WS_W4T = 58 * MiB;
constexpr size_t WS_HB  = 90 * MiB;
constexpr size_t WS_QB  = 124 * MiB;
constexpr size_t WS_KB  = 141 * MiB;
constexpr size_t WS_VB  = 158 * MiB;
constexpr size_t WS_UB  = 175 * MiB;
constexpr size_t WS_LF  = 192 * MiB;
constexpr size_t WS_FC  = 193 * MiB;
constexpr size_t WS_DEC = 194 * MiB;
constexpr size_t WS_ASB = 199 * MiB;
constexpr size_t WS_T   = 233 * MiB;
constexpr size_t WS_X1  = 298 * MiB;
constexpr size_t WS_AB  = 363 * MiB;
constexpr size_t WS_Q   = 493 * MiB;
constexpr size_t WS_U   = 527 * MiB;
constexpr size_t WS_AS  = 561 * MiB;
constexpr size_t WS_SC  = 626 * MiB;
constexpr size_t WS_PO  = 660 * MiB;
constexpr size_t WS_PML = 665 * MiB;
constexpr size_t WS_LAM = 666 * MiB;
constexpr size_t WS_BB  = 667 * MiB;
constexpr size_t WS_CC  = 668 * MiB;
constexpr size_t WS_WG  = 669 * MiB;
constexpr size_t WS_SEND = 670 * MiB;
constexpr size_t WS_PART = 700 * MiB;
constexpr size_t WS_SPART = 704 * MiB;
constexpr size_t WS_END = 712 * MiB;

static_assert(WS_KB - WS_QB == 17 * MiB && WS_VB - WS_KB == 17 * MiB && WS_UB - WS_VB == 17 * MiB && WS_U - WS_Q == 34 * MiB && O_VP - O_KP == (size_t)MP * AW, "EpiQKVU pointer arithmetic");
struct P {
    const float *xp, *xs, *cp, *cs, *ck, *cv, *clf, *sre, *sim; const int* pt;
    const float *w_ada, *b_ada, *w_in, *b_f, *w_o, *a_re, *a_im, *log_dt, *b_re, *b_im, *c_re, *c_im, *d_skip, *w_glu, *b_glu,
                *ln1_g, *ln1_b, *w_up, *w_down, *ln2_g, *ln2_b;
    float* out; unsigned char* ws;
    int ph_lo, ph_hi, li, pad;
};
__device__ __forceinline__ const float* xrow(const P& p, int m) { return m < MP ? p.xp + (size_t)m * D : p.xs + (size_t)(m - MP) * D; }
__device__ __forceinline__ int brow(int m) { return m < MP ? m / SEQ : NB + (m - MP) / DS; }
__device__ __forceinline__ float* modp(const P& p, int b, int i) { return (float*)(p.ws + WS_MOD) + (size_t)b * NMOD * D + (size_t)i * D; }
__device__ __forceinline__ float log_sigmoid(float x) { return fminf(x, 0.f) - log1pf(__expf(-fabsf(x))); }

namespace pg8 {
#define PG8_LAS __attribute__((address_space(3)))
typedef unsigned short bf16_t;
typedef short bf16x8 __attribute__((ext_vector_type(8)));
typedef float f32x4 __attribute__((ext_vector_type(4)));
typedef unsigned u32x4 __attribute__((ext_vector_type(4)));
constexpr int BM = 256, BK = 64, HALF = 128, HTB = HALF * BK * 2  , STAGE_BYTES = 8 * HTB, NXCD = 8, WGM = 8;

__host__ __device__ __forceinline__ int lds_byte(int r, int c) { const int st = (r >> 4) * 2 + (c >> 5), rr = r & 15, cc = c & 31, ob = rr * 64 + cc * 2; return st * 1024 + (ob ^ (((ob >> 9) & 1) << 5)); }
__host__ __device__ __forceinline__ void stage_rc(int b, int& R, int& C) { const int st = b / 1024, sb = b % 1024, swz = sb ^ (((sb >> 9) & 1) << 5); R = (st >> 1) * 16 + swz / 64; C = (st & 1) * 32 + (swz % 64) / 2; }
__host__ __device__ __forceinline__ int perm32(int rho) { const int n = rho >> 4, i = rho & 15; return 8 * (i >> 2) + 4 * n + (i & 3); }

struct Unit { int pm, pn; };
struct Gemm { const bf16_t* A; const bf16_t* Bt; int M, N, K; };

struct StaticOrder {
    int nM, nN, nwg, G, c;
    __host__ __device__ void init(int M, int N, int G_, int c_) { nM = M / BM; nN = N / BM; nwg = nM * nN; G = G_; c = c_; }
    __host__ __device__ bool next(int i, Unit& u) const {
        const long L = (long)i * G + c; if (L >= nwg) return false;
        int wgid = (int)L; { const int q = nwg / NXCD, r = nwg % NXCD, xcd = wgid % NXCD, off = wgid / NXCD; wgid = (xcd < r ? xcd * (q + 1) : r * (q + 1) + (xcd - r) * q) + off; }
        const int nig = WGM * nN, gid = wgid / nig, fm = gid * WGM, gsz = (nM - fm) < WGM ? (nM - fm) : WGM;
        u.pm = fm + ((wgid % nig) % gsz); u.pn = (wgid % nig) / gsz; return true;
    }
    __device__ __forceinline__ void a_ready(const Unit&) const {}
    __device__ __forceinline__ void done(const Unit&) const {}
};

__device__ __forceinline__ unsigned cvt_pk_bf16(float lo, float hi) { unsigned r; asm volatile("v_cvt_pk_bf16_f32 %0, %1, %2" : "=v"(r) : "v"(lo), "v"(hi)); return r; }
typedef float f32x2 __attribute__((ext_vector_type(2)));
struct EpiQKVU {
    static constexpr bool PERM = true, AFTER_DRAIN = false;
    bf16_t *Qb, *Kb, *Vb, *Ub; float *outK, *outV; float *Qf, *Uf;
    __device__ __forceinline__ void operator()(const f32x4 (&acc)[2][2][4][2], const Unit& u, int wr, int wc, int fr, int fq) const {
        const int region = u.pn >> 2, colt = (u.pn & 3) * BM;
        const int row0 = u.pm * BM + wr * 64 + fr, col0 = colt + wc * 32 + 8 * fq;
        bf16_t* ob = Qb + (size_t)region * (17u << 19);
        float* of = (region == 1 || region == 2) ? outK + (size_t)(region - 1) * ((size_t)8192 * 1024) : (Qf ? Qf + (size_t)(region / 3) * (34u << 18) : nullptr);
#pragma unroll
        for (int ai = 0; ai < 2; ++ai)
#pragma unroll
            for (int m = 0; m < 4; ++m) { const size_t ro = (size_t)(row0 + ai * HALF + m * 16) * 1024 + col0;
#pragma unroll
                for (int bj = 0; bj < 2; ++bj) { const f32x4 v0 = acc[ai][bj][m][0], v1 = acc[ai][bj][m][1];
                    u32x4 w; w.x = cvt_pk_bf16(v0[0], v0[1]); w.y = cvt_pk_bf16(v0[2], v0[3]); w.z = cvt_pk_bf16(v1[0], v1[1]); w.w = cvt_pk_bf16(v1[2], v1[3]);
                    *(u32x4*)(ob + ro + bj * HALF) = w;
                    if (of) { __builtin_nontemporal_store(v0, (f32x4*)(of + ro + bj * HALF)); __builtin_nontemporal_store(v1, (f32x4*)(of + ro + bj * HALF + 4)); } } }
    }
};
template <bool BASE_F32> struct EpiRes {
    static constexpr bool PERM = true, AFTER_DRAIN = false;
    const void* base; const float* gate0; bf16_t* T;
    __device__ __forceinline__ void operator()(const f32x4 (&acc)[2][2][4][2], const Unit& u, int wr, int wc, int fr, int fq) const {
        const int row0 = u.pm * BM + wr * 64 + fr, col0 = u.pn * BM + wc * 32 + 8 * fq;
        const float* gb = gate0 + (size_t)((u.pm * BM) / 4096) * (6 * 2048);
#pragma unroll
        for (int bj = 0; bj < 2; ++bj) { const int col = col0 + bj * HALF; const f32x4 g0 = *(const f32x4*)(gb + col) + 1.0f, g1 = *(const f32x4*)(gb + col + 4) + 1.0f;
#pragma unroll
            for (int ai = 0; ai < 2; ++ai)
#pragma unroll
                for (int m = 0; m < 4; ++m) { const size_t off = (size_t)(row0 + ai * HALF + m * 16) * 2048 + col;
                    f32x4 b0, b1;
                    if (BASE_F32) { b0 = *(const f32x4*)((const float*)base + off); b1 = *(const f32x4*)((const float*)base + off + 4); }
                    else { const u32x4 w = *(const u32x4*)((const bf16_t*)base + off);
                        b0 = (f32x4){__builtin_bit_cast(float, w.x << 16), __builtin_bit_cast(float, w.x & 0xffff0000u), __builtin_bit_cast(float, w.y << 16), __builtin_bit_cast(float, w.y & 0xffff0000u)};
                        b1 = (f32x4){__builtin_bit_cast(float, w.z << 16), __builtin_bit_cast(float, w.z & 0xffff0000u), __builtin_bit_cast(float, w.w << 16), __builtin_bit_cast(float, w.w & 0xffff0000u)}; }
                    const f32x4 t0 = b0 * 1.189207115002721f + g0 * acc[ai][bj][m][0], t1 = b1 * 1.189207115002721f + g1 * acc[ai][bj][m][1];
                    u32x4 o; o.x = cvt_pk_bf16(t0[0], t0[1]); o.y = cvt_pk_bf16(t0[2], t0[3]); o.z = cvt_pk_bf16(t1[0], t1[1]); o.w = cvt_pk_bf16(t1[2], t1[3]);
                    *(u32x4*)(T + off) = o; } }
    }
};
struct EpiRelu2 {
    static constexpr bool PERM = true, AFTER_DRAIN = false;
    bf16_t* O; int ldc;
    __device__ __forceinline__ void operator()(const f32x4 (&acc)[2][2][4][2], const Unit& u, int wr, int wc, int fr, int fq) const {
        const int row0 = u.pm * BM + wr * 64 + fr, col0 = u.pn * BM + wc * 32 + 8 * fq;
#pragma unroll
        for (int ai = 0; ai < 2; ++ai)
#pragma unroll
            for (int m = 0; m < 4; ++m) { bf16_t* rowp = O + (size_t)(row0 + ai * HALF + m * 16) * ldc + col0;
#pragma unroll
                for (int bj = 0; bj < 2; ++bj) { f32x4 v0 = acc[ai][bj][m][0], v1 = acc[ai][bj][m][1];
                    v0 = __builtin_elementwise_max(v0, (f32x4){0.f, 0.f, 0.f, 0.f}); v1 = __builtin_elementwise_max(v1, (f32x4){0.f, 0.f, 0.f, 0.f}); v0 = v0 * v0; v1 = v1 * v1;
                    u32x4 w; w.x = cvt_pk_bf16(v0[0], v0[1]); w.y = cvt_pk_bf16(v0[2], v0[3]); w.z = cvt_pk_bf16(v1[0], v1[1]); w.w = cvt_pk_bf16(v1[2], v1[3]);
                    *(u32x4*)(rowp + bj * HALF) = w; } }
    }
};
template <class Epi, class Sched, bool ALIGN_EPI = false, bool SP2 = false>
__device__ __forceinline__ void gemm_phase(PG8_LAS unsigned char* lds, const Gemm g, const Sched& S, const Epi& E, const int tid_in) {
    const int tid = tid_in, wid = __builtin_amdgcn_readfirstlane(tid >> 6), lane = tid & 63, wr = wid >> 2, wc = wid & 3, fr = lane & 15, fq = lane >> 4;
    const int K = g.K, nt = K / BK;
    unsigned voffA[2], voffB[2];
#pragma unroll
    for (int i = 0; i < 2; ++i) { int R, C; stage_rc(tid * 16 + i * 8192, R, C); const int Rb = Epi::PERM ? ((R & ~31) + perm32(R & 31)) : R;
        voffA[i] = (unsigned)(R * K + C) * 2u; voffB[i] = (unsigned)(Rb * K + C) * 2u; }
    const size_t kstep = (size_t)(BK * 2);
    const size_t hstep = (size_t)HALF * K * 2;
    const size_t tstep = 2 * hstep;
    const unsigned ldsw = (unsigned)wid * 1024u;
    const int aoff = lds_byte(wr * 64 + fr, fq * 8), boff = lds_byte(wc * 32 + fr, fq * 8);
#define PG8_SA(b, h) (((b) * 2 + (h)) * HTB)
#define PG8_SB(b, h) ((4 + (b) * 2 + (h)) * HTB)
#define PG8_STAGE(bufoff, gbase, voff) do { _Pragma("unroll") for (int _i = 0; _i < 2; ++_i) \
        __builtin_amdgcn_global_load_lds((const unsigned*)((const char*)(gbase) + (voff)[_i]), (PG8_LAS unsigned*)(lds + (bufoff) + ldsw + _i * 8192), 16, 0, 0); } while (0)
#define PG8_LDA(dst, b, h) do { _Pragma("unroll") for (int m = 0; m < 4; ++m) _Pragma("unroll") for (int k = 0; k < 2; ++k) dst[m][k] = *(const PG8_LAS bf16x8*)(lds + PG8_SA(b, h) + aoff + m * 2048 + k * 1024); } while (0)
#define PG8_LDB(dst, b, h) do { _Pragma("unroll") for (int n = 0; n < 2; ++n) _Pragma("unroll") for (int k = 0; k < 2; ++k) dst[n][k] = *(const PG8_LAS bf16x8*)(lds + PG8_SB(b, h) + boff + n * 2048 + k * 1024); } while (0)
#define PG8_MMA(ai, bj, At, Bt) do { __builtin_amdgcn_s_setprio(1); _Pragma("unroll") for (int m = 0; m < 4; ++m) _Pragma("unroll") for (int n = 0; n < 2; ++n) _Pragma("unroll") for (int k = 0; k < 2; ++k) \
        acc[ai][bj][m][n] = __builtin_amdgcn_mfma_f32_16x16x32_bf16(Bt[n][k], At[m][k], acc[ai][bj][m][n], 0, 0, 0); __builtin_amdgcn_s_setprio(0); } while (0)
#define PG8_WAIT_V(n) asm volatile("s_waitcnt vmcnt(" #n ")" ::: "memory")
#define PG8_WAIT_L(n) asm volatile("s_waitcnt lgkmcnt(" #n ")" ::: "memory")
#define PG8_BAR __builtin_amdgcn_s_barrier()
#define PG8_SCHED __builtin_amdgcn_sched_barrier(0)
    Unit cur, nxt; int ui = 0;
    if (!S.next(0, cur)) return;
    f32x4 acc[2][2][4][2];
#pragma unroll
    for (int a = 0; a < 2; ++a)
#pragma unroll
        for (int b = 0; b < 2; ++b)
#pragma unroll
            for (int m = 0; m < 4; ++m)
#pragma unroll
                for (int n = 0; n < 2; ++n) acc[a][b][m][n] = (f32x4){0.f, 0.f, 0.f, 0.f};
    bf16x8 At[4][2], B0[2][2], B1[2][2];
    const char* cA = (const char*)g.A + (size_t)cur.pm * tstep; const char* cB = (const char*)g.Bt + (size_t)cur.pn * tstep;
    S.a_ready(cur);
    if constexpr (SP2) {
        PG8_STAGE(PG8_SB(0, 0), cB, voffB); PG8_STAGE(PG8_SB(0, 1), cB + hstep, voffB); PG8_STAGE(PG8_SA(0, 0), cA, voffA); PG8_STAGE(PG8_SA(0, 1), cA + hstep, voffA);
        if (wr == 1) PG8_BAR;
        PG8_WAIT_V(2); PG8_BAR;
        PG8_STAGE(PG8_SB(1, 0), cB + kstep, voffB); PG8_STAGE(PG8_SA(1, 0), cA + kstep, voffA); PG8_STAGE(PG8_SB(1, 1), cB + hstep + kstep, voffB);
        PG8_WAIT_V(6); PG8_BAR;
    } else {
        PG8_STAGE(PG8_SB(0, 0), cB, voffB); PG8_STAGE(PG8_SA(0, 0), cA, voffA); PG8_STAGE(PG8_SB(0, 1), cB + hstep, voffB); PG8_STAGE(PG8_SA(0, 1), cA + hstep, voffA);
        if (wr == 1) PG8_BAR;
        PG8_WAIT_V(4); PG8_BAR;
        PG8_STAGE(PG8_SB(1, 0), cB + kstep, voffB); PG8_STAGE(PG8_SA(1, 0), cA + kstep, voffA); PG8_STAGE(PG8_SB(1, 1), cB + hstep + kstep, voffB);
        PG8_WAIT_V(6); PG8_BAR;
    }
    for (;;) {
        const bool has_next = S.next(ui + 1, nxt);
        const char* nA = has_next ? (const char*)g.A + (size_t)nxt.pm * tstep : cA; const char* nB = has_next ? (const char*)g.Bt + (size_t)nxt.pn * tstep : cB;
        for (int t = 0; t < nt; t += 2) {
            const bool last = (t == nt - 2);
            const char* a1 = cA + (size_t)(t + 1) * kstep;
            const char* a2 = last ? nA : cA + (size_t)(t + 2) * kstep; const char* b2 = last ? nB : cB + (size_t)(t + 2) * kstep;
            const char* a3 = a2 + kstep; const char* b3 = b2 + kstep;
            if (last && has_next) S.a_ready(nxt);
            if constexpr (SP2) {
            PG8_LDB(B0, 0, 0); PG8_LDB(B1, 0, 1); PG8_SCHED; PG8_LDA(At, 0, 0); PG8_STAGE(PG8_SA(1, 1), a1 + hstep, voffA);
            PG8_WAIT_V(8); PG8_WAIT_L(0); PG8_BAR; PG8_MMA(0, 0, At, B0); PG8_MMA(0, 1, At, B1); PG8_BAR; PG8_SCHED;
            PG8_LDA(At, 0, 1); PG8_STAGE(PG8_SB(0, 0), b2, voffB); PG8_STAGE(PG8_SB(0, 1), b2 + hstep, voffB); PG8_STAGE(PG8_SA(0, 0), a2, voffA);
            PG8_WAIT_V(8); PG8_WAIT_L(0); PG8_BAR; PG8_MMA(1, 0, At, B0); PG8_MMA(1, 1, At, B1); PG8_BAR; PG8_SCHED;
            PG8_LDB(B0, 1, 0); PG8_LDB(B1, 1, 1); PG8_SCHED; PG8_LDA(At, 1, 0); PG8_STAGE(PG8_SA(0, 1), a2 + hstep, voffA);
            PG8_WAIT_V(8); PG8_WAIT_L(0); PG8_BAR; PG8_MMA(0, 0, At, B0); PG8_MMA(0, 1, At, B1); PG8_BAR; PG8_SCHED;
            PG8_LDA(At, 1, 1); PG8_STAGE(PG8_SB(1, 0), b3, voffB); PG8_STAGE(PG8_SB(1, 1), b3 + hstep, voffB); PG8_STAGE(PG8_SA(1, 0), a3, voffA);
            PG8_WAIT_V(8); PG8_WAIT_L(0); PG8_BAR; PG8_MMA(1, 0, At, B0); PG8_MMA(1, 1, At, B1); PG8_BAR; PG8_SCHED;
            } else {
            PG8_LDB(B0, 0, 0); PG8_SCHED; PG8_LDA(At, 0, 0); PG8_STAGE(PG8_SA(1, 1), a1 + hstep, voffA);
            PG8_WAIT_L(8); PG8_BAR; PG8_WAIT_L(0); PG8_MMA(0, 0, At, B0); PG8_BAR; PG8_SCHED;
            PG8_LDB(B1, 0, 1); PG8_STAGE(PG8_SB(0, 0), b2, voffB);
            PG8_BAR; PG8_WAIT_L(0); PG8_MMA(0, 1, At, B1); PG8_BAR;
            PG8_LDA(At, 0, 1); PG8_STAGE(PG8_SA(0, 0), a2, voffA);
            PG8_BAR; PG8_WAIT_L(0); PG8_MMA(1, 0, At, B0); PG8_BAR; PG8_SCHED;
            PG8_STAGE(PG8_SB(0, 1), b2 + hstep, voffB);
            PG8_WAIT_V(6); PG8_BAR; PG8_MMA(1, 1, At, B1); PG8_BAR;
            PG8_LDB(B0, 1, 0); PG8_SCHED; PG8_LDA(At, 1, 0); PG8_STAGE(PG8_SA(0, 1), a2 + hstep, voffA);
            PG8_WAIT_L(8); PG8_BAR; PG8_WAIT_L(0); PG8_MMA(0, 0, At, B0); PG8_BAR; PG8_SCHED;
            PG8_LDB(B1, 1, 1); PG8_STAGE(PG8_SB(1, 0), b3, voffB);
            PG8_BAR; PG8_WAIT_L(0); PG8_MMA(0, 1, At, B1); PG8_BAR;
            PG8_LDA(At, 1, 1); PG8_STAGE(PG8_SA(1, 0), a3, voffA);
            PG8_BAR; PG8_WAIT_L(0); PG8_MMA(1, 0, At, B0); PG8_BAR; PG8_SCHED;
            PG8_STAGE(PG8_SB(1, 1), b3 + hstep, voffB);
            PG8_WAIT_V(6); PG8_BAR; PG8_MMA(1, 1, At, B1); PG8_BAR;
            }
        }
        if constexpr (ALIGN_EPI) { if (wr == 0) PG8_BAR; }
        if constexpr (!Epi::AFTER_DRAIN) { E(acc, cur, wr, wc, fr, fq); S.done(cur); }
        if (!has_next) break;
#pragma unroll
        for (int a = 0; a < 2; ++a)
#pragma unroll
            for (int b = 0; b < 2; ++b)
#pragma unroll
                for (int m = 0; m < 4; ++m)
#pragma unroll
                    for (int n = 0; n < 2; ++n) acc[a][b][m][n] = (f32x4){0.f, 0.f, 0.f, 0.f};
        cur = nxt; cA = nA; cB = nB; ++ui;
        if constexpr (ALIGN_EPI) { if (wr == 1) PG8_BAR; }
    }
    PG8_WAIT_V(0);
    if constexpr (!ALIGN_EPI) { if (wr == 0) PG8_BAR; }
    PG8_BAR;
    if constexpr (Epi::AFTER_DRAIN) { E.fused(acc, cur, wr, wc, fr, fq, lds, wid, lane); S.done(cur); }
#undef PG8_SA
#undef PG8_SB
#undef PG8_STAGE
#undef PG8_LDA
#undef PG8_LDB
#undef PG8_MMA
#undef PG8_WAIT_V
#undef PG8_WAIT_L
#undef PG8_BAR
#undef PG8_SCHED
}
}
constexpr int NWAVES = 8;
constexpr int RING_OFF = 0, RING_BYTES = 131072;
constexpr int LDSCTL_OFF = RING_BYTES, MISC_OFF = LDSCTL_OFF + 320;
constexpr int LDS_BYTES = 163840;
constexpr int DEC_PEX_OFF = 132096;
constexpr int CW_TMO = 0, CW_CODE = 1, CW_MOD = 1024, CW_SSMA = 2048, CW_BAR = 4096, CW_SK = 16384;

#define GAS __attribute__((address_space(1)))
#define LAS __attribute__((address_space(3)))
typedef unsigned short bf16;
typedef unsigned v4u __attribute__((ext_vector_type(4)));
typedef unsigned v2u __attribute__((ext_vector_type(2)));
typedef float f32x4 __attribute__((ext_vector_type(4)));
typedef float f32x2 __attribute__((ext_vector_type(2)));
typedef short bf16x8 __attribute__((ext_vector_type(8)));
typedef GAS unsigned gu32;
#define RLX_AGENT __ATOMIC_RELAXED, __HIP_MEMORY_SCOPE_AGENT
#define LDS_WAIT() asm volatile("s_waitcnt lgkmcnt(0)" ::: "memory")
#define VM_WAIT() asm volatile("s_waitcnt vmcnt(0)" ::: "memory")
__device__ __forceinline__ unsigned f2bf(float f) { unsigned u = __builtin_bit_cast(unsigned, f); return (u + 0x7fffu + ((u >> 16) & 1u)) >> 16; }
typedef __bf16 pk_bf16x2 __attribute__((ext_vector_type(2)));
__device__ __forceinline__ unsigned pk2(float lo, float hi) { f32x2 v = {lo, hi}; return __builtin_bit_cast(unsigned, __builtin_convertvector(v, pk_bf16x2)); }
template <int CTRL> __device__ __forceinline__ float dpp_mov(float x) { return __builtin_bit_cast(float, __builtin_amdgcn_mov_dpp(__builtin_bit_cast(int, x), CTRL, 0xf, 0xf, true)); }
__device__ __forceinline__ float rows_sum(float x) {
    auto s = __builtin_amdgcn_permlane16_swap(__float_as_uint(x), __float_as_uint(x), false, false); x = __uint_as_float(s[0]) + __uint_as_float(s[1]);
    auto t = __builtin_amdgcn_permlane32_swap(__float_as_uint(x), __float_as_uint(x), false, false); return __uint_as_float(t[0]) + __uint_as_float(t[1]); }
__device__ __forceinline__ float wave_sum(float v) {
    v += dpp_mov<0xB1>(v);
    v += dpp_mov<0x4E>(v);
    v += dpp_mov<0x141>(v);
    v += dpp_mov<0x128>(v);
    return rows_sum(v);
}
#define XB_TMO      128
#define XB_XCNT(j)  (256  + 64 * (j))
#define XB_XSUB(j)  (1280 + 64 * (j))
#define XB_XGEN(j)  (2304 + 64 * (j))
#define XB_TOP      3328
#define XB_TOPGEN   3392
#define XCD_BAR_WORDS 3456
#define XB_SPIN_CAP (1u << 18)

__device__ __forceinline__ unsigned xb_ld(unsigned* p)              { return __hip_atomic_load(p, __ATOMIC_RELAXED, __HIP_MEMORY_SCOPE_AGENT); }
__device__ __forceinline__ unsigned xb_add(unsigned* p, unsigned v) { return __hip_atomic_fetch_add(p, v, __ATOMIC_RELAXED, __HIP_MEMORY_SCOPE_AGENT); }
__device__ __forceinline__ unsigned xb_xcc_id() { return (unsigned)__builtin_amdgcn_s_getreg((3 << 11) | 20) & 0xFu; }
#define XB_SPIN(cond, bar) do { unsigned _sp = 0; while (cond) { __builtin_amdgcn_s_sleep(1); \
    if ((++_sp & 255u) == 0u) { if (xb_ld(&(bar)[XB_TMO])) break; if (_sp > XB_SPIN_CAP) { atomicAdd(&(bar)[XB_TMO], 1u); break; } } } } while (0)

struct XcdBarrier {
    unsigned* bar; unsigned x;
    volatile LAS unsigned* st;
};

__device__ __forceinline__ XcdBarrier xcd_barrier_post(unsigned* bar, volatile LAS unsigned* st, const int tid) {
    XcdBarrier b; b.bar = bar; b.x = xb_xcc_id(); b.st = st;
    if (tid == 0) (void)xb_add(&bar[XB_XCNT(b.x)], 1u);
    return b;
}
__device__ __forceinline__ void xcd_barrier_complete(unsigned* bar, unsigned x, unsigned& nloc, unsigned& nx) {
    const unsigned G = gridDim.x * gridDim.y * gridDim.z;
    unsigned sum, cnt, mine, sp = 0u;
    for (;;) {
        sum = 0u; cnt = 0u; mine = 0u;
#pragma unroll
        for (unsigned j = 0; j < 16; ++j) { const unsigned c = xb_ld(&bar[XB_XCNT(j)]); sum += c; cnt += (c > 0u) ? 1u : 0u; mine = (j == x) ? c : mine; }
        if (sum == G) break;
        __builtin_amdgcn_s_sleep(1);
        if ((++sp & 255u) == 0u) { if (xb_ld(&bar[XB_TMO])) break; if (sp > XB_SPIN_CAP) { atomicAdd(&bar[XB_TMO], 1u); break; } }
    }
    nloc = mine > 0u ? mine : 1u; nx = cnt > 0u ? cnt : 1u;
}

__device__ __forceinline__ void xcd_barrier(const XcdBarrier& b, const int tid) {
    asm volatile("s_waitcnt vmcnt(0)" ::: "memory");
    __syncthreads();
    if (tid == 0) {
        unsigned* bar = b.bar;
        __builtin_amdgcn_s_waitcnt(0);
        unsigned nloc = b.st[0], nx = b.st[1];
        if (nloc == 0u) { xcd_barrier_complete(bar, b.x, nloc, nx); b.st[0] = nloc; b.st[1] = nx; }
        const unsigned old = xb_add(&bar[XB_XSUB(b.x)], 1u);
        const unsigned gen = old / nloc;
        if (old + 1u == (gen + 1u) * nloc) {
            __builtin_amdgcn_fence(__ATOMIC_RELEASE, "agent");
            asm volatile("s_waitcnt vmcnt(0)" ::: "memory");
            const unsigned og = xb_add(&bar[XB_TOP], 1u);
            const unsigned tg = og / nx;
            if (og + 1u == (tg + 1u) * nx) xb_add(&bar[XB_TOPGEN], 1u);
            else XB_SPIN(xb_ld(&bar[XB_TOPGEN]) == tg, bar);
            __builtin_amdgcn_fence(__ATOMIC_ACQUIRE, "agent");
            xb_add(&bar[XB_XGEN(b.x)], 1u);
            asm volatile("s_waitcnt vmcnt(0)" ::: "memory");
        } else {
            XB_SPIN(xb_ld(&bar[XB_XGEN(b.x)]) == gen, bar);
            __builtin_amdgcn_fence(__ATOMIC_ACQUIRE, "agent");
            asm volatile("s_waitcnt vmcnt(0)" ::: "memory");
        }
    }
    __syncthreads();
}


struct Frame { LAS unsigned char* lds; int tid, lane, wave, G, bid; };

namespace ssm {
typedef short bf16x8 __attribute__((ext_vector_type(8)));
typedef short s16x4 __attribute__((ext_vector_type(4)));
typedef float f32x16 __attribute__((ext_vector_type(16)));
typedef float f32x4 __attribute__((ext_vector_type(4)));
typedef float f32x2 __attribute__((ext_vector_type(2)));
typedef __bf16 bf16x2_t __attribute__((ext_vector_type(2)));
typedef unsigned u32x4 __attribute__((ext_vector_type(4)));
typedef unsigned u32x2 __attribute__((ext_vector_type(2)));
typedef short v4i16_t __attribute__((ext_vector_type(4)));
constexpr int CH = 64, NCH = SEQ / CH;
constexpr int ROWB = 72, IMGB = 32 * ROWB, WIMG = 4 * IMGB;
#define MFMA32(a, b, c) __builtin_amdgcn_mfma_f32_32x32x16_bf16((a), (b), (c), 0, 0, 0)
__device__ __forceinline__ unsigned cvtpk_s(float lo, float hi) { f32x2 v = {lo, hi}; bf16x2_t b = __builtin_convertvector(v, bf16x2_t); return __builtin_bit_cast(unsigned, b); }
__device__ __forceinline__ float bf_lo(unsigned w) { return __builtin_bit_cast(float, w << 16); }
__device__ __forceinline__ float bf_hi(unsigned w) { return __builtin_bit_cast(float, w & 0xffff0000u); }
__device__ __forceinline__ float gelu_tanh_f(float x) { const float a = 1.5957691216057308f * (x + 0.044715f * x * x * x); return x / (1.f + __expf(-a)); }

__device__ __forceinline__ void build_tables(const P& p, int g, int lane) {
    float* LAM = (float*)(p.ws + WS_LAM) + (size_t)g * 128; unsigned short* BB = (unsigned short*)(p.ws + WS_BB) + (size_t)g * 128 * 16;
    unsigned short* CC = (unsigned short*)(p.ws + WS_CC) + (size_t)g * 16 * 128; unsigned short* WG = (unsigned short*)(p.ws + WS_WG) + (size_t)g * 512;
    const float are = p.a_re[g * SP + lane], aim = p.a_im[g * SP + lane], dt = expf(p.log_dt[g]);
    const float mag = expf(are * dt), lr = mag * cosf(aim * dt), li = mag * sinf(aim * dt);
    const float den = are * are + aim * aim, nre = lr - 1.f;
    const float kre = (nre * are + li * aim) / den, kim = (li * are - nre * aim) / den;
    LAM[lane] = lr; LAM[64 + lane] = li;
#pragma unroll
    for (int c = 0; c < SG; c += 2) {
        const float br0 = p.b_re[(size_t)(g * SP + lane) * SG + c], bi0 = p.b_im[(size_t)(g * SP + lane) * SG + c], br1 = p.b_re[(size_t)(g * SP + lane) * SG + c + 1], bi1 = p.b_im[(size_t)(g * SP + lane) * SG + c + 1];
        *(unsigned*)(BB + (size_t)lane * 16 + c) = pk2(kre * br0 - kim * bi0, kre * br1 - kim * bi1);
        *(unsigned*)(BB + (size_t)(64 + lane) * 16 + c) = pk2(kre * bi0 + kim * br0, kre * bi1 + kim * br1);
    }
#pragma unroll
    for (int co = 0; co < SG; ++co) { CC[co * 128 + lane] = (unsigned short)f2bf(p.c_re[(size_t)(g * SG + co) * SP + lane]); CC[co * 128 + 64 + lane] = (unsigned short)f2bf(-p.c_im[(size_t)(g * SG + co) * SP + lane]); }
#pragma unroll
    for (int i = 0; i < 8; ++i) { const int idx = lane * 8 + i, j = idx & 7, e = (idx >> 3) & 31, h = idx >> 8, co = 8 * (j >> 2) + 4 * h + (j & 3);
        WG[idx] = (unsigned short)f2bf(p.w_glu[(size_t)(g * SG + co) * 2 * SG + e]); }
}
struct Tab { float lr[2], li[2]; bf16x8 bfrag[4]; bf16x8 ccfrag[8]; bf16x8 wgfrag; f32x4 dsk[2], bgv[2], bgg[2]; };
template <bool OUT>
__device__ __forceinline__ void load_tab(const P& p, int g, int lane, Tab& T) {
    const int c32 = lane & 31, hi = lane >> 5;
    const float* LAM = (const float*)(p.ws + WS_LAM) + (size_t)g * 128; const unsigned short* BB = (const unsigned short*)(p.ws + WS_BB) + (size_t)g * 128 * 16;
#pragma unroll
    for (int pb = 0; pb < 2; ++pb) { T.lr[pb] = LAM[c32 + 32 * pb]; T.li[pb] = LAM[64 + c32 + 32 * pb]; }
#pragma unroll
    for (int cb = 0; cb < 4; ++cb) T.bfrag[cb] = *(const bf16x8*)(BB + (size_t)(32 * cb + c32) * 16 + 8 * hi);
    if (OUT) {
        const unsigned short* CC = (const unsigned short*)(p.ws + WS_CC) + (size_t)g * 16 * 128; const unsigned short* WG = (const unsigned short*)(p.ws + WS_WG) + (size_t)g * 512;
#pragma unroll
        for (int s = 0; s < 8; ++s) { bf16x8 v = {0, 0, 0, 0, 0, 0, 0, 0}; if (c32 < 16) v = *(const bf16x8*)(CC + (size_t)c32 * 128 + 16 * s + 8 * hi); T.ccfrag[s] = v; }
        T.wgfrag = *(const bf16x8*)(WG + (size_t)(hi * 32 + c32) * 8);
#pragma unroll
        for (int q = 0; q < 2; ++q) { T.dsk[q] = *(const f32x4*)(p.d_skip + g * SG + 8 * q + 4 * hi); T.bgv[q] = *(const f32x4*)(p.b_glu + g * 2 * SG + 8 * q + 4 * hi); T.bgg[q] = *(const f32x4*)(p.b_glu + g * 2 * SG + SG + 8 * q + 4 * hi); }
    }
}
template <int MODE>
__device__ __forceinline__ void unit(const P& p, const Tab& T, int g, int cidx  , int lane, LAS unsigned char* img) {
    const int c32 = lane & 31, hi = lane >> 5;
    const unsigned short* Ub = (const unsigned short*)(p.ws + WS_UB);
    float hr[2], hm[2];
    const float (&lr)[2] = T.lr; const float (&li)[2] = T.li; const bf16x8 (&bfrag)[4] = T.bfrag;
#pragma unroll
    for (int pb = 0; pb < 2; ++pb) { hr[pb] = 0.f; hm[pb] = 0.f; }
    const int th = (c32 >> 2) & 1, tr = (c32 & 3) + 4 * (c32 >> 3);
    int rbA, rbD;
    if (MODE == 2) { rbA = MP + (cidx + 4 * th) * DS; rbD = MP + (cidx + 4 * hi) * DS; } else { rbA = th * SEQ + cidx * CH; rbD = hi * SEQ + cidx * CH; }
    if (MODE == 1 && cidx > 0) {
        float pr[2], pi[2];
#pragma unroll
        for (int pb = 0; pb < 2; ++pb) { float a = lr[pb], b = li[pb];
#pragma unroll
            for (int k = 0; k < 6; ++k) { const float na = a * a - b * b, nb = 2.f * a * b; a = na; b = nb; }
            pr[pb] = a; pi[pb] = b; }
        const float* S = (const float*)(p.ws + WS_SEND) + ((size_t)(hi * NG + g) * NCH) * 128 + c32;
        for (int j0 = 0; j0 < cidx; j0 += 8) {
            float sv[8][4];
#pragma unroll
            for (int jj = 0; jj < 8; ++jj) { const int j = (j0 + jj < cidx) ? j0 + jj : cidx - 1;
#pragma unroll
                for (int pb = 0; pb < 2; ++pb) { sv[jj][pb] = S[(size_t)j * 128 + 32 * pb]; sv[jj][2 + pb] = S[(size_t)j * 128 + 64 + 32 * pb]; } }
#pragma unroll
            for (int jj = 0; jj < 8; ++jj) if (j0 + jj < cidx) {
#pragma unroll
                for (int pb = 0; pb < 2; ++pb) { const float nr = pr[pb] * hr[pb] - pi[pb] * hm[pb] + sv[jj][pb], ni = pr[pb] * hm[pb] + pi[pb] * hr[pb] + sv[jj][2 + pb]; hr[pb] = nr; hm[pb] = ni; } }
        }
    }
    if (MODE == 2) {
#pragma unroll
        for (int pb = 0; pb < 2; ++pb) { hr[pb] = p.sre[(size_t)((cidx + 4 * hi) * NG + g) * SP + c32 + 32 * pb]; hm[pb] = p.sim[(size_t)((cidx + 4 * hi) * NG + g) * SP + c32 + 32 * pb]; }
    }
    const bf16x8 (&ccfrag)[8] = T.ccfrag; const bf16x8& wgfrag = T.wgfrag; const f32x4 (&dsk)[2] = T.dsk; const f32x4 (&bgv)[2] = T.bgv; const f32x4 (&bgg)[2] = T.bgg;
    float fr[2] = {0.f, 0.f}, fm[2] = {0.f, 0.f};
    constexpr int NSB = MODE == 2 ? 1 : CH / 16;
    const int trA = MODE == 2 ? (tr < DS ? tr : DS - 1) : tr;
    bf16x8 afn = *(const bf16x8*)(Ub + (size_t)(rbA + trA) * SW + g * SG + 8 * hi);
    u32x2 u0n = {0u, 0u}, u1n = {0u, 0u};
    if (MODE != 0) { u0n = *(const u32x2*)(Ub + (size_t)(rbA + trA) * SW + g * SG + 4 * hi); u1n = *(const u32x2*)(Ub + (size_t)(rbA + trA) * SW + g * SG + 8 + 4 * hi); }
    for (int sb = 0; sb < NSB; ++sb) {
        const bf16x8 afrag = afn; const u32x2 u0 = u0n, u1 = u1n;
        if (sb + 1 < NSB) { const size_t rn = (size_t)(rbA + 16 * (sb + 1) + trA) * SW + g * SG; afn = *(const bf16x8*)(Ub + rn + 8 * hi);
            if (MODE != 0) { u0n = *(const u32x2*)(Ub + rn + 4 * hi); u1n = *(const u32x2*)(Ub + rn + 8 + 4 * hi); } }
        const f32x16 zero = {0.f, 0.f, 0.f, 0.f, 0.f, 0.f, 0.f, 0.f, 0.f, 0.f, 0.f, 0.f, 0.f, 0.f, 0.f, 0.f};
        f32x16 bu[4];
#pragma unroll
        for (int cb = 0; cb < 4; ++cb) bu[cb] = MFMA32(afrag, bfrag[cb], zero);
#pragma unroll
        for (int r = 0; r < 16; ++r) {
#pragma unroll
            for (int pb = 0; pb < 2; ++pb) { const float nr = lr[pb] * hr[pb] - li[pb] * hm[pb] + bu[pb][r], ni = lr[pb] * hm[pb] + li[pb] * hr[pb] + bu[2 + pb][r];
                hr[pb] = nr; hm[pb] = ni; bu[pb][r] = nr; bu[2 + pb][r] = ni; }
            if (MODE == 2 && r == DS - 1) { fr[0] = hr[0]; fr[1] = hr[1]; fm[0] = hm[0]; fm[1] = hm[1]; }
        }
        if (MODE == 0) continue;
#pragma unroll
        for (int cb = 0; cb < 4; ++cb)
#pragma unroll
            for (int g4 = 0; g4 < 4; ++g4) { u32x2 w; w.x = cvtpk_s(bu[cb][4 * g4], bu[cb][4 * g4 + 1]); w.y = cvtpk_s(bu[cb][4 * g4 + 2], bu[cb][4 * g4 + 3]);
                *(LAS u32x2*)(img + cb * IMGB + c32 * ROWB + 8 * (2 * g4 + hi)) = w; }
        asm volatile("s_waitcnt lgkmcnt(0)" ::: "memory");
        f32x16 yt = zero;
        { const int i16 = lane & 15, q = i16 >> 2, pp = i16 & 3, blk = (lane >> 4) & 1;
#pragma unroll
          for (int s = 0; s < 8; ++s) { const LAS unsigned char* tp = img + (s >> 1) * IMGB + (16 * (s & 1) + 8 * hi + q) * ROWB + 8 * (4 * blk + pp);
              const s16x4 lo = __builtin_bit_cast(s16x4, __builtin_amdgcn_ds_read_tr16_b64_v4i16((LAS v4i16_t*)tp));
              const s16x4 hh = __builtin_bit_cast(s16x4, __builtin_amdgcn_ds_read_tr16_b64_v4i16((LAS v4i16_t*)(tp + 4 * ROWB)));
              const bf16x8 xa = {lo[0], lo[1], lo[2], lo[3], hh[0], hh[1], hh[2], hh[3]};
              yt = MFMA32(ccfrag[s], xa, yt); } }
        asm volatile("s_waitcnt lgkmcnt(0)" ::: "memory");
        const int tok = 16 * sb + tr; const bool live = MODE == 2 ? tr < DS : true;
        const size_t mrow = (size_t)(rbA + (MODE == 2 ? trA : tok));
        float z[8];
        z[0] = gelu_tanh_f(yt[0] + dsk[0][0] * bf_lo(u0.x)); z[1] = gelu_tanh_f(yt[1] + dsk[0][1] * bf_hi(u0.x)); z[2] = gelu_tanh_f(yt[2] + dsk[0][2] * bf_lo(u0.y)); z[3] = gelu_tanh_f(yt[3] + dsk[0][3] * bf_hi(u0.y));
        z[4] = gelu_tanh_f(yt[4] + dsk[1][0] * bf_lo(u1.x)); z[5] = gelu_tanh_f(yt[5] + dsk[1][1] * bf_hi(u1.x)); z[6] = gelu_tanh_f(yt[6] + dsk[1][2] * bf_lo(u1.y)); z[7] = gelu_tanh_f(yt[7] + dsk[1][3] * bf_hi(u1.y));
        u32x4 zp; zp.x = cvtpk_s(z[0], z[1]); zp.y = cvtpk_s(z[2], z[3]); zp.z = cvtpk_s(z[4], z[5]); zp.w = cvtpk_s(z[6], z[7]);
        const f32x16 zz = MFMA32(wgfrag, __builtin_bit_cast(bf16x8, zp), zero);
        float o[8];
#pragma unroll
        for (int i = 0; i < 8; ++i) { const float gate = zz[i + 8] + bgg[i >> 2][i & 3]; o[i] = (zz[i] + bgv[i >> 2][i & 3]) / (1.f + __expf(-gate)); }
        if (live) { unsigned short* ob = (unsigned short*)(p.ws + WS_ASB) + mrow * D + AW + g * SG;
            u32x2 w0, w1; w0.x = cvtpk_s(o[0], o[1]); w0.y = cvtpk_s(o[2], o[3]); w1.x = cvtpk_s(o[4], o[5]); w1.y = cvtpk_s(o[6], o[7]);
            *(u32x2*)(ob + 4 * hi) = w0; *(u32x2*)(ob + 8 + 4 * hi) = w1; }
    }
    if (MODE == 0) { float* S = (float*)(p.ws + WS_SEND) + ((size_t)(hi * NG + g) * NCH + cidx) * 128 + c32;
#pragma unroll
        for (int pb = 0; pb < 2; ++pb) { S[32 * pb] = hr[pb]; S[64 + 32 * pb] = hm[pb]; } }
    if (MODE == 1 && cidx == NCH - 1) {
#pragma unroll
        for (int pb = 0; pb < 2; ++pb) { p.out[O_SRP + (size_t)(hi * NG + g) * SP + c32 + 32 * pb] = hr[pb]; p.out[O_SIP + (size_t)(hi * NG + g) * SP + c32 + 32 * pb] = hm[pb]; } }
    if (MODE == 2) {
#pragma unroll
        for (int pb = 0; pb < 2; ++pb) { p.out[O_SRS + (size_t)((cidx + 4 * hi) * NG + g) * SP + c32 + 32 * pb] = fr[pb]; p.out[O_SIS + (size_t)((cidx + 4 * hi) * NG + g) * SP + c32 + 32 * pb] = fm[pb]; } }
}
#undef MFMA32
}

__device__ __forceinline__ float block_incl_scan(float tot, LAS float* sh, int tid, int lane, int wave, float& all) {
    float v = tot;
#pragma unroll
    for (int o = 1; o < 64; o <<= 1) { const float n = __shfl_up(v, o); if (lane >= o) v += n; }
    __syncthreads();
    if (lane == 63) sh[wave] = v;
    __syncthreads();
    float off = 0.f, a = 0.f;
#pragma unroll
    for (int w = 0; w < NWAVES; ++w) { const float t = sh[w]; if (w < wave) off += t; a += t; }
    all = a; return v + off;
}
__device__ __forceinline__ void scan_fc(const P& p, Frame& F, int bh) {
    const int b = bh / NH, h = bh % NH; const float* lf = (const float*)(p.ws + WS_LF); float* fc = (float*)(p.ws + WS_FC) + (size_t)bh * SEQ;
    float v[8]; float s = 0.f;
#pragma unroll
    for (int i = 0; i < 8; ++i) { s += lf[(size_t)(b * SEQ + F.tid * 8 + i) * NH + h]; v[i] = s; }
    float all; const float incl = block_incl_scan(s, (LAS float*)F.lds, F.tid, F.lane, F.wave, all); const float off = incl - s;
#pragma unroll
    for (int i = 0; i < 8; ++i) fc[F.tid * 8 + i] = off + v[i];
    __syncthreads();
}
__device__ __forceinline__ void scan_dec(const P& p, Frame& F, int bh) {
    const int b = bh / NH, h = bh % NH; float* dec = (float*)(p.ws + WS_DEC) + (size_t)bh * PAST;
    const int pos0 = F.tid * 32; const int pg = p.pt[b * NPG + pos0 / PAGE];
    const float* src = p.clf + ((size_t)pg * PAGE + (pos0 % PAGE)) * NH + h;
    float v[32]; float s = 0.f;
#pragma unroll
    for (int i = 31; i >= 0; --i) { v[i] = s; s += src[(size_t)i * NH]; }
    float all; const float incl = block_incl_scan(s, (LAS float*)F.lds, F.tid, F.lane, F.wave, all); const float off = all - incl;
#pragma unroll
    for (int i = 0; i < 32; ++i) dec[pos0 + i] = off + v[i];
    __syncthreads();
}

__device__ __forceinline__ void p0_transpose_item(const float* W, int ldw, int K, int ncols, bf16* WT, int row_off, int item, int lane) {
    const int nblk = ncols / 64, kb = item / nblk, nb = item % nblk, k0 = 64 * kb, n0 = 64 * nb, cq = lane & 15, rg = lane >> 4;
    const float* src = W + (size_t)(k0 + 8 * rg) * ldw + n0 + 4 * cq;
    f32x4 f[2][8];
#pragma unroll
    for (int h = 0; h < 2; ++h)
#pragma unroll
        for (int i = 0; i < 8; ++i) f[h][i] = __builtin_nontemporal_load((const f32x4*)(src + (size_t)(32 * h + i) * ldw));
    bf16* dst = WT + (size_t)(row_off + n0 + 4 * cq) * K + k0 + 8 * rg;
#pragma unroll
    for (int h = 0; h < 2; ++h)
#pragma unroll
        for (int e = 0; e < 4; ++e) { v4u o; o.x = pk2(f[h][0][e], f[h][1][e]); o.y = pk2(f[h][2][e], f[h][3][e]); o.z = pk2(f[h][4][e], f[h][5][e]); o.w = pk2(f[h][6][e], f[h][7][e]);
            *(GAS v4u*)(dst + (size_t)e * K + 32 * h) = o; }
}
__device__ __forceinline__ void p0_mod(const P& p, Frame& F) {
    LAS float* S = (LAS float*)F.lds;
    const int kc = F.bid / 24, nc = F.bid % 24;
    for (int idx = F.tid; idx < NBT * 256; idx += NWAVES * 64) { const int r = idx >> 8, k = idx & 255; const float c = r < NB ? p.cp[r * D + 256 * kc + k] : p.cs[(r - NB) * D + 256 * kc + k];
        S[k * 12 + r] = c / (1.f + expf(-c)); }
    __syncthreads();
    const int n0 = 512 * nc + 64 * F.wave, cg = F.lane & 15, rq = F.lane >> 4;
    f32x4 acc[NBT];
#pragma unroll
    for (int r = 0; r < NBT; ++r) acc[r] = (f32x4){0.f, 0.f, 0.f, 0.f};
    const float* wp = p.w_ada + (size_t)(256 * kc + rq) * (NMOD * D) + n0 + 4 * cg;
#pragma unroll 8
    for (int it = 0; it < 64; ++it) {
        const f32x4 wv = __builtin_nontemporal_load((const f32x4*)(wp + (size_t)(4 * it) * (NMOD * D)));
        const LAS float* sk = S + (4 * it + rq) * 12;
        const f32x4 s0 = *(const LAS f32x4*)sk, s1 = *(const LAS f32x4*)(sk + 4); const f32x2 s2 = *(const LAS f32x2*)(sk + 8);
        acc[0] += wv * s0[0]; acc[1] += wv * s0[1]; acc[2] += wv * s0[2]; acc[3] += wv * s0[3];
        acc[4] += wv * s1[0]; acc[5] += wv * s1[1]; acc[6] += wv * s1[2]; acc[7] += wv * s1[3];
        acc[8] += wv * s2[0]; acc[9] += wv * s2[1];
    }
#pragma unroll
    for (int r = 0; r < NBT; ++r)
#pragma unroll
        for (int e = 0; e < 4; ++e) acc[r][e] = rows_sum(acc[r][e]);
    if (rq == 0) { float* part = (float*)(p.ws + WS_PART) + (size_t)kc * NBT * NMOD * D + n0 + 4 * cg;
#pragma unroll
        for (int r = 0; r < NBT; ++r) *(f32x4*)(part + (size_t)r * NMOD * D) = acc[r]; }
    VM_WAIT(); __syncthreads();
    if (F.tid == 0) { __builtin_amdgcn_fence(__ATOMIC_RELEASE, "agent"); VM_WAIT(); (void)xb_add((unsigned*)p.ws + CW_MOD, 1u); }
}
__device__ __forceinline__ float mod_reduce(const P& p, int idx  ) {
    const float* part = (const float*)(p.ws + WS_PART) + idx; float v = p.b_ada[idx % (NMOD * D)];
#pragma unroll
    for (int kc = 0; kc < 8; ++kc) v += part[(size_t)kc * NBT * NMOD * D];
    return v;
}
__device__ __forceinline__ void p0_prologue(const P& p, Frame& F) {
    constexpr int NMODWG = NMOD * D / 64;
    if (F.bid < NMODWG) p0_mod(p, F);
    else if (F.G == 256) { scan_dec(p, F, F.bid - NMODWG);
        if (F.bid < NMODWG + 8) ssm::build_tables(p, (F.bid - NMODWG) * NWAVES + F.wave, F.lane); }
    bf16* W1T = (bf16*)(p.ws + WS_W1T); bf16* W2T = (bf16*)(p.ws + WS_W2T); bf16* W3T = (bf16*)(p.ws + WS_W3T); bf16* W4T = (bf16*)(p.ws + WS_W4T);
    constexpr int I_1A = (D / 64) * (3 * AW / 64), I_1B = (D / 64) * (SW / 64), I_2 = (D / 64) * (D / 64), I_3 = (D / 64) * (DFF / 64), I_4 = (DFF / 64) * (D / 64);
    constexpr int NITEMS = I_1A + I_1B + I_2 + I_3 + I_4;
    constexpr int TS = NMODWG * NWAVES * 2 + (256 - NMODWG) * NWAVES * 3;
    int slot0, nsl;
    int sstep = 1;
    if (F.G == 256) { sstep = NWAVES; if (F.bid < NMODWG) { slot0 = F.bid * NWAVES * 2 + F.wave; nsl = 2; } else { slot0 = NMODWG * NWAVES * 2 + (F.bid - NMODWG) * NWAVES * 3 + F.wave; nsl = 3; } }
    else { slot0 = F.bid * NWAVES + F.wave; nsl = 1; }
    const int stride = F.G == 256 ? TS : F.G * NWAVES;
    for (int sl = 0; sl < nsl; ++sl)
        for (int it = slot0 + sl * sstep; it < NITEMS; it += stride) {
            int r = it;
            if (r < I_1A) { p0_transpose_item(p.w_in, INC, D, 3 * AW, W1T, 0, r, F.lane); continue; } r -= I_1A;
            if (r < I_1B) { p0_transpose_item(p.w_in + 3 * AW + NH, INC, D, SW, W1T, 3 * AW, r, F.lane); continue; } r -= I_1B;
            if (r < I_2) { p0_transpose_item(p.w_o, D, D, D, W2T, 0, r, F.lane); continue; } r -= I_2;
            if (r < I_3) { p0_transpose_item(p.w_up, DFF, D, DFF, W3T, 0, r, F.lane); continue; } r -= I_3;
            p0_transpose_item(p.w_down, D, DFF, D, W4T, 0, r, F.lane);
        }
}
__device__ __forceinline__ void row_stats(const f32x4 (&v)[8], float& mean, float& rstd) {
    float s = 0.f;
#pragma unroll
    for (int j = 0; j < 8; ++j) s += (v[j][0] + v[j][1]) + (v[j][2] + v[j][3]);
    mean = wave_sum(s) * (1.f / D); float q = 0.f;
#pragma unroll
    for (int j = 0; j < 8; ++j) { const f32x4 d = v[j] - mean; q += (d[0] * d[0] + d[1] * d[1]) + (d[2] * d[2] + d[3] * d[3]); }
    rstd = 1.f / sqrtf(wave_sum(q) * (1.f / D) + LN_EPS);
}
__device__ __forceinline__ void phase_l0(const P& p, Frame& F, unsigned* tmo_bar) {
    LAS float* WF = (LAS float*)F.lds;
    LAS float* ML = (LAS float*)(F.lds + 65536);
#pragma unroll 8
    for (int idx = F.tid; idx < D * NH; idx += NWAVES * 64) { const int c = idx >> 3, hh = idx & 7;
        WF[((((c >> 8) * 4 + (c & 3)) * 2 + (hh >> 2)) * 64 + ((c & 255) >> 2)) * 4 + (hh & 3)] = p.w_in[(size_t)c * INC + 3 * AW + hh]; }
    if (F.tid == 0) { XB_SPIN(xb_ld((unsigned*)p.ws + CW_MOD) < (unsigned)(NMOD * D / 64), tmo_bar); __builtin_amdgcn_fence(__ATOMIC_ACQUIRE, "agent"); VM_WAIT(); }
    __syncthreads();
    { float* mod = (float*)(p.ws + WS_MOD);
      if (F.G == 256) { if (F.tid < 480) { const int idx = F.bid * 480 + F.tid; mod[idx] = mod_reduce(p, idx); } }
      else for (int idx = F.bid * NWAVES * 64 + F.tid; idx < NBT * NMOD * D; idx += F.G * NWAVES * 64) mod[idx] = mod_reduce(p, idx);
      const int nsel = (F.bid < DB) ? 3 : 2;
      for (int i0 = 0; i0 < nsel * 2 * D; i0 += 8 * NWAVES * 64) { float v[8];
#pragma unroll
          for (int k = 0; k < 8; ++k) { const int idx = i0 + k * NWAVES * 64 + F.tid, bsel = idx / (2 * D), rem = idx % (2 * D), b = bsel < 2 ? bsel : NB + F.bid; v[k] = mod_reduce(p, b * NMOD * D + rem); }
#pragma unroll
          for (int k = 0; k < 8; ++k) { const int idx = i0 + k * NWAVES * 64 + F.tid, rem = idx % (2 * D); ML[idx] = rem < D ? v[k] : 1.0f + v[k]; } } }
    __syncthreads();
    bf16* Hb = (bf16*)(p.ws + WS_HB); float* LF = (float*)(p.ws + WS_LF);
    const int gw = F.bid * NWAVES + F.wave, NGW = F.G * NWAVES;
    f32x4 nv[8];
    if (gw < M) { const GAS f32x4* xr = (const GAS f32x4*)xrow(p, gw) + F.lane;
#pragma unroll
        for (int j = 0; j < 8; ++j) nv[j] = xr[64 * j]; }
    for (int m = gw; m < M; m += NGW) {
        f32x4 v[8];
#pragma unroll
        for (int j = 0; j < 8; ++j) v[j] = nv[j];
        if (m + NGW < M) { const GAS f32x4* xr = (const GAS f32x4*)xrow(p, m + NGW) + F.lane;
#pragma unroll
            for (int j = 0; j < 8; ++j) nv[j] = xr[64 * j]; }
        float mean, rstd; row_stats(v, mean, rstd);
        const int bsel = m < MP ? m / SEQ : 2;
        const LAS f32x4* sh1 = (const LAS f32x4*)(ML + bsel * 2 * D) + F.lane; const LAS f32x4* sc1 = (const LAS f32x4*)(ML + bsel * 2 * D + D) + F.lane;
        GAS v2u* o8 = (GAS v2u*)(Hb + (size_t)m * D) + F.lane;
        f32x2 fp[4];
#pragma unroll
        for (int e = 0; e < 4; ++e) fp[e] = (f32x2){0.f, 0.f};
#pragma unroll
        for (int j = 0; j < 8; ++j) {
            const f32x4 h = (v[j] - mean) * rstd * sc1[64 * j] + sh1[64 * j];
            v2u o; o.x = pk2(h[0], h[1]); o.y = pk2(h[2], h[3]); o8[64 * j] = o;
            const LAS f32x4* wf = (const LAS f32x4*)WF + j * 512 + F.lane;
#pragma unroll
            for (int e = 0; e < 4; ++e) { const f32x4 w0 = wf[(2 * e) * 64], w1 = wf[(2 * e + 1) * 64]; const f32x2 hh = {h[e], h[e]};
                fp[0] += hh * (f32x2){w0[0], w0[1]}; fp[1] += hh * (f32x2){w0[2], w0[3]}; fp[2] += hh * (f32x2){w1[0], w1[1]}; fp[3] += hh * (f32x2){w1[2], w1[3]}; }
            asm volatile("" ::: "memory");
        }
        float fl[8];
#pragma unroll
        for (int e = 0; e < 8; ++e) fl[e] = wave_sum(fp[e >> 1][e & 1]);
        if (F.lane < 8) {
            float f = fl[0];
#pragma unroll
            for (int e = 1; e < 8; ++e) f = (F.lane == e) ? fl[e] : f;
            const float lf = log_sigmoid(f + p.b_f[F.lane]);
            LF[(size_t)m * NH + F.lane] = lf;
            if (m < MP) p.out[O_LFP + (size_t)m * NH + F.lane] = lf; else p.out[O_LFS + (size_t)(m - MP) * NH + F.lane] = lf;
        }
    }
    __syncthreads();
}
__device__ __forceinline__ f32x4 unpk4(v2u w) { return (f32x4){__builtin_bit_cast(float, w.x << 16), __builtin_bit_cast(float, w.x & 0xffff0000u), __builtin_bit_cast(float, w.y << 16), __builtin_bit_cast(float, w.y & 0xffff0000u)}; }
__device__ __forceinline__ void phase_l1(const P& p, Frame& F) {
    bf16* Hb = (bf16*)(p.ws + WS_HB); const bf16* T = (const bf16*)(p.ws + WS_T); bf16* X1 = (bf16*)(p.ws + WS_X1);
    const int gw = F.bid * NWAVES + F.wave, NGW = F.G * NWAVES;
    f32x4 g1[8], b1[8];
#pragma unroll
    for (int j = 0; j < 8; ++j) { g1[j] = ((const GAS f32x4*)p.ln1_g + F.lane)[64 * j]; b1[j] = ((const GAS f32x4*)p.ln1_b + F.lane)[64 * j]; }
    v2u nv[8];
    if (gw < M) { const GAS v2u* tr = (const GAS v2u*)(T + (size_t)gw * D) + F.lane;
#pragma unroll
        for (int j = 0; j < 8; ++j) nv[j] = tr[64 * j]; }
    for (int m = gw; m < M; m += NGW) {
        f32x4 v[8];
#pragma unroll
        for (int j = 0; j < 8; ++j) v[j] = unpk4(nv[j]);
        if (m + NGW < M) { const GAS v2u* tr = (const GAS v2u*)(T + (size_t)(m + NGW) * D) + F.lane;
#pragma unroll
            for (int j = 0; j < 8; ++j) nv[j] = tr[64 * j]; }
        const int b = brow(m);
        const GAS f32x4* sh2 = (const GAS f32x4*)modp(p, b, 3) + F.lane; const GAS f32x4* sc2 = (const GAS f32x4*)modp(p, b, 4) + F.lane;
        f32x4 s2[8], h2[8];
#pragma unroll
        for (int j = 0; j < 8; ++j) { s2[j] = sc2[64 * j]; h2[j] = sh2[64 * j]; }
        float mean, rstd; row_stats(v, mean, rstd);
        GAS v2u* xo = (GAS v2u*)(X1 + (size_t)m * D) + F.lane;
#pragma unroll
        for (int j = 0; j < 8; ++j) { v[j] = (v[j] - mean) * rstd * g1[j] + b1[j]; v2u o; o.x = pk2(v[j][0], v[j][1]); o.y = pk2(v[j][2], v[j][3]); xo[64 * j] = o; }
        row_stats(v, mean, rstd);
        GAS v2u* o8 = (GAS v2u*)(Hb + (size_t)m * D) + F.lane;
#pragma unroll
        for (int j = 0; j < 8; ++j) { const f32x4 h = (v[j] - mean) * rstd * (s2[j] + 1.0f) + h2[j];
            v2u o; o.x = pk2(h[0], h[1]); o.y = pk2(h[2], h[3]); o8[64 * j] = o; }
    }
}
__device__ __forceinline__ void phase_l2(const P& p, Frame& F) {
    const bf16* T = (const bf16*)(p.ws + WS_T);
    const int gw = F.bid * NWAVES + F.wave, NGW = F.G * NWAVES;
    f32x4 g2[8], b2[8];
#pragma unroll
    for (int j = 0; j < 8; ++j) { g2[j] = ((const GAS f32x4*)p.ln2_g + F.lane)[64 * j]; b2[j] = ((const GAS f32x4*)p.ln2_b + F.lane)[64 * j]; }
    v2u nv[8];
    if (gw < M) { const GAS v2u* tr = (const GAS v2u*)(T + (size_t)gw * D) + F.lane;
#pragma unroll
        for (int j = 0; j < 8; ++j) nv[j] = tr[64 * j]; }
    for (int m = gw; m < M; m += NGW) {
        f32x4 v[8];
#pragma unroll
        for (int j = 0; j < 8; ++j) v[j] = unpk4(nv[j]);
        if (m + NGW < M) { const GAS v2u* tr = (const GAS v2u*)(T + (size_t)(m + NGW) * D) + F.lane;
#pragma unroll
            for (int j = 0; j < 8; ++j) nv[j] = tr[64 * j]; }
        float mean, rstd; row_stats(v, mean, rstd);
        GAS f32x4* yo = (GAS f32x4*)(m < MP ? p.out + O_YP + (size_t)m * D : p.out + O_YS + (size_t)(m - MP) * D) + F.lane;
#pragma unroll
        for (int j = 0; j < 8; ++j) yo[64 * j] = (v[j] - mean) * rstd * g2[j] + b2[j];
    }
}
template <int NST, class Epi>
__device__ __forceinline__ void skinny_gemm(Frame& F, const bf16* A, const bf16* Bt, int N, int K, unsigned* cnt, unsigned char* ws, size_t part_off, const Epi& E) {
    constexpr int KC = 512, PITCH = KC * 2 + 16, WPS = NWAVES / NST, KSW = 16 / WPS, NC = 16 * NST;
    LAS unsigned char* As = F.lds;
    LAS float* red = (LAS float*)(F.lds + 67584);
    LAS unsigned* flag = (LAS unsigned*)(F.lds + 67584 + 32768);
    const int nks = K / KC, nns = N / NC, r16 = F.lane & 15, kq = F.lane >> 4;
    const __amdgpu_buffer_rsrc_t rw = __builtin_amdgcn_make_buffer_rsrc((void*)ws, (short)0, 0x7fffffff, 0x00020000);
    for (int u = F.bid; u < nks * nns; u += F.G) {
        const int ns = u % nns, ks = u / nns;
        { const int row = F.wave * 8 + (F.lane >> 3), seg = F.lane & 7; const bf16* src = A + (size_t)row * K + ks * KC + seg * 8; v4u t[8];
#pragma unroll
          for (int i = 0; i < 8; ++i) t[i] = *(const GAS v4u*)(src + i * 64);
#pragma unroll
          for (int i = 0; i < 8; ++i) *(LAS v4u*)(As + row * PITCH + (i * 8 + seg) * 16) = t[i]; }
        const int strip = F.wave % NST, kpart = F.wave / NST;
        const bf16* bp = Bt + (size_t)(ns * NC + strip * 16 + r16) * K + ks * KC + kpart * KSW * 32 + 8 * kq;
        bf16x8 bq[KSW];
#pragma unroll
        for (int j = 0; j < KSW; ++j) bq[j] = *(const bf16x8*)(bp + 32 * j);
        __syncthreads();
        f32x4 acc[4];
#pragma unroll
        for (int rb = 0; rb < 4; ++rb) acc[rb] = (f32x4){0.f, 0.f, 0.f, 0.f};
#pragma unroll
        for (int j = 0; j < KSW; ++j)
#pragma unroll
            for (int rb = 0; rb < 4; ++rb) { const bf16x8 a = *(const LAS bf16x8*)(As + (rb * 16 + r16) * PITCH + ((kpart * KSW + j) * 32 + 8 * kq) * 2);
                acc[rb] = __builtin_amdgcn_mfma_f32_16x16x32_bf16(a, bq[j], acc[rb], 0, 0, 0); }
#pragma unroll
        for (int rb = 0; rb < 4; ++rb)
#pragma unroll
            for (int i = 0; i < 4; ++i) red[(F.wave * 64 + rb * 16 + 4 * kq + i) * 16 + r16] = acc[rb][i];
        __syncthreads();
        for (int e = F.tid; e < 64 * NC / 4; e += NWAVES * 64) { const int row = e / (NC / 4), c4 = (e % (NC / 4)) * 4, st = c4 >> 4; f32x4 v = {0.f, 0.f, 0.f, 0.f};
#pragma unroll
            for (int w = 0; w < WPS; ++w) v += *(const LAS f32x4*)(red + ((w * NST + st) * 64 + row) * 16 + (c4 & 15));
            __builtin_amdgcn_raw_buffer_store_b128(__builtin_bit_cast(v4u, v), rw, (int)(part_off + (((size_t)ks * 64 + row) * N + ns * NC + c4) * 4), 0, 16  ); }
        VM_WAIT(); __syncthreads();
        if (F.tid == 0) { const unsigned old = xb_add(cnt + 16 * ns, 1u); const unsigned last = (old == (unsigned)(nks - 1)) ? 1u : 0u;
            if (last) { __builtin_amdgcn_fence(__ATOMIC_ACQUIRE, "agent"); VM_WAIT(); } flag[0] = last; }
        __syncthreads();
        if (flag[0]) {
            const float* p0 = (const float*)(ws + part_off) + ns * NC;
            for (int e = F.tid; e < 64 * NC / 4; e += NWAVES * 64) { const int row = e / (NC / 4), c4 = (e % (NC / 4)) * 4; f32x4 v = {0.f, 0.f, 0.f, 0.f};
                for (int k2 = 0; k2 < nks; ++k2) v += *(const f32x4*)(p0 + ((size_t)k2 * 64 + row) * N + c4);
#pragma unroll
                for (int i = 0; i < 4; ++i) E(row, ns * NC + c4 + i, v[i]); } }
        __syncthreads();
    }
}
struct SEpi1 { const P* p;
    __device__ __forceinline__ void operator()(int row, int n, float v) const { const P& q = *p; const int region = n >> 10, c = n & 1023; const size_t o = (size_t)(MP + row) * 1024 + c; const bf16 h = (bf16)f2bf(v);
        if (region == 0) { ((bf16*)(q.ws + WS_QB))[o] = h; }
        else if (region == 1) { ((bf16*)(q.ws + WS_KB))[o] = h; q.out[O_KS + (size_t)row * 1024 + c] = v; }
        else if (region == 2) { ((bf16*)(q.ws + WS_VB))[o] = h; q.out[O_VS + (size_t)row * 1024 + c] = v; }
        else { ((bf16*)(q.ws + WS_UB))[o] = h; } } };
template <bool BASE_F32> struct SEpiRes { const P* p; const void* base; int gi;
    __device__ __forceinline__ void operator()(int row, int n, float v) const { const P& q = *p;
        const float bs = BASE_F32 ? ((const float*)base)[(size_t)row * D + n] : __builtin_bit_cast(float, (unsigned)((const bf16*)base)[(size_t)row * D + n] << 16);
        ((bf16*)(q.ws + WS_T))[(size_t)(MP + row) * D + n] = (bf16)f2bf(ALPHA * bs + (1.f + modp(q, NB + row / DS, gi)[n]) * v); } };
struct SEpiRelu2 { const P* p;
    __device__ __forceinline__ void operator()(int row, int n, float v) const { const float r = fmaxf(v, 0.f); ((bf16*)(p->ws + WS_AB))[(size_t)(MP + row) * DFF + n] = (bf16)f2bf(r * r); } };

namespace att {
constexpr int D = 128, RS = 1024  , OS = 2048  ; constexpr float THR = 8.f; constexpr bool WSKIP = false;
constexpr float SCALE = 0.08838834764831845f, RSCALE = 11.313708498984761f;
constexpr int NW = 8, QBLK = 32, KVBLK = 64, QB = NW * QBLK;
constexpr int SHM_V = KVBLK * D * 2, SHM_K = KVBLK * D * 2;
constexpr int LDS_FJ = 2 * SHM_V + 2 * SHM_K + NW * 64 * 4;
constexpr int LDS_BYTES = LDS_FJ + 2 * 256;

using bf16 = unsigned short;
typedef short bf16x8 __attribute__((ext_vector_type(8)));
typedef short s16x4 __attribute__((ext_vector_type(4)));
typedef float f32x16 __attribute__((ext_vector_type(16)));
typedef float f32x4 __attribute__((ext_vector_type(4)));
typedef unsigned u32x4 __attribute__((ext_vector_type(4)));
template <class A, class Bt> struct same_t { static constexpr bool v = false; };
template <class A> struct same_t<A, A> { static constexpr bool v = true; };

#define KSWZ(row, colB) ((row) * 256 + ((colB) ^ (((row) & 7) << 4)))
#define SBAR() __builtin_amdgcn_sched_barrier(0)
__device__ __forceinline__ int v_st(int k, int c) { const int kk = (k & ~0xC) | ((k & 4) << 1) | ((k & 8) >> 1); return ((kk >> 3) * 4 + (c >> 5)) * 512 + ((kk & 7) * 32 + (c & 31)) * 2; }
__device__ __forceinline__ int v_rd_base(int lane) { return ((lane & 3) << 3) | (((lane >> 2) & 3) << 6) | (((lane >> 4) & 1) << 5) | (((lane >> 5) & 1) << 8); }
constexpr int v_rd_off(int d0, int ks, int half) { return d0 * 512 + ks * 4096 + half * 2048; }
__device__ __forceinline__ int crow(int r, int hi) { return (r & 3) + 8 * (r >> 2) + 4 * hi; }
__device__ __forceinline__ unsigned cvtpk(float lo, float hi) {
    unsigned r; asm volatile("v_cvt_pk_bf16_f32 %0, %1, %2" : "=v"(r) : "v"(lo), "v"(hi)); return r;
}
__device__ __forceinline__ bf16x8 pack8(f32x4 a, f32x4 b) {
    u32x4 w = {cvtpk(a[0], a[1]), cvtpk(a[2], a[3]), cvtpk(b[0], b[1]), cvtpk(b[2], b[3])};
    return *reinterpret_cast<bf16x8*>(&w);
}
template <class T> __device__ __forceinline__ bf16x8 load8(const T* p) {
    if constexpr (same_t<T, float>::v) { return pack8(*(const f32x4*)p, *(const f32x4*)(p + 4)); }
    else { return *reinterpret_cast<const bf16x8*>(p); }
}
__device__ __forceinline__ void mask_tile(f32x16& p0, f32x16& p1, int dq, unsigned W) {
    const float NEG = -__builtin_inff();
#pragma unroll
    for (int r = 0; r < 16; ++r) {
        const int c = (r & 3) + 8 * (r >> 2);
        if ((unsigned)(dq - c) >= W) p0[r] = NEG;
        if ((unsigned)(dq - c - 32) >= W) p1[r] = NEG;
    }
}
__device__ __forceinline__ void partialSM(f32x16& p0, f32x16& p1, float& m_reg, float& mn, float& alpha) {
    float pmax = p0[0]; for (int r = 1; r < 16; ++r) pmax = fmaxf(pmax, p0[r]); for (int r = 0; r < 16; ++r) pmax = fmaxf(pmax, p1[r]);
    { auto rr = __builtin_amdgcn_permlane32_swap(__float_as_uint(pmax), __float_as_uint(pmax), false, false);
      pmax = fmaxf(__uint_as_float(rr[0]), __uint_as_float(rr[1])); }
    constexpr float C2 = 1.4426950408889634f * SCALE;
    if (__builtin_expect(__all((pmax - m_reg) * SCALE <= THR), 1)) { mn = m_reg; alpha = 1.f; }
    else { mn = fmaxf(m_reg, pmax); alpha = __builtin_amdgcn_exp2f((m_reg - mn) * C2); m_reg = mn; }
    const float mnL = -mn * C2;
    for (int r = 0; r < 16; ++r) p0[r] = fmaf(p0[r], C2, mnL); for (int r = 0; r < 16; ++r) p1[r] = fmaf(p1[r], C2, mnL);
    for (int r = 0; r < 16; ++r) p0[r] = __builtin_amdgcn_exp2f(p0[r]);
}
__device__ __forceinline__ void finishSM(f32x16& p0, f32x16& p1, float alpha, float& l_reg, bf16x8& pa0, bf16x8& pa1, bf16x8& pa2, bf16x8& pa3) {
    for (int r = 0; r < 16; ++r) p1[r] = __builtin_amdgcn_exp2f(p1[r]);
    float ps = 0; for (int r = 0; r < 16; ++r) ps += p0[r]; for (int r = 0; r < 16; ++r) ps += p1[r];
    { auto rr = __builtin_amdgcn_permlane32_swap(__float_as_uint(ps), __float_as_uint(ps), false, false);
      ps = __uint_as_float(rr[0]) + __uint_as_float(rr[1]); }
    l_reg = l_reg * alpha + ps;
#define PK4(P, B_, OUT) do { unsigned a0 = cvtpk(P[B_+0], P[B_+1]), a1 = cvtpk(P[B_+2], P[B_+3]);                          \
        unsigned b0 = cvtpk(P[B_+4], P[B_+5]), b1 = cvtpk(P[B_+6], P[B_+7]);                                             \
        auto r0 = __builtin_amdgcn_permlane32_swap(a0, b0, false, false); auto r1 = __builtin_amdgcn_permlane32_swap(a1, b1, false, false); \
        u32x4 w = {r0[0], r1[0], r0[1], r1[1]}; OUT = *reinterpret_cast<bf16x8*>(&w); } while (0)
    PK4(p0, 0, pa0); PK4(p0, 8, pa1); PK4(p1, 0, pa2); PK4(p1, 8, pa3);
#undef PK4
}
template <int KB, bool SK>
__device__ __forceinline__ void qkt(f32x16& p0, f32x16& p1, const char* K_lds, int r32, int hi, const bf16x8* qr, bool act, float fi) {
    if (SK && !act) { const float NEG = -__builtin_inff();
#pragma unroll
        for (int r = 0; r < 16; ++r) { p0[r] = NEG; p1[r] = NEG; } return; }
    { const char* fjp = K_lds + 2 * SHM_K + NW * 64 * 4 + KB * 256 + hi * 16;
#pragma unroll
      for (int g = 0; g < 4; ++g) { const f32x4 a = *reinterpret_cast<const f32x4*>(fjp + 32 * g), b = *reinterpret_cast<const f32x4*>(fjp + 128 + 32 * g);
#pragma unroll
        for (int e = 0; e < 4; ++e) { p0[4 * g + e] = fi - a[e]; p1[4 * g + e] = fi - b[e]; } } }
    const char* kb[4];
#pragma unroll
    for (int dd = 0; dd < 4; ++dd) kb[dd] = K_lds + KB * SHM_K + KSWZ(r32, (dd * 16 + hi * 8) * 2);
#pragma unroll
    for (int d0 = 0; d0 < 8; ++d0) { const char* a = kb[d0 & 3] + (d0 >> 2) * 128;
        bf16x8 b0 = *reinterpret_cast<const bf16x8*>(a);
        bf16x8 b1 = *reinterpret_cast<const bf16x8*>(a + 32 * 256);
        p0 = __builtin_amdgcn_mfma_f32_32x32x16_bf16(b0, qr[d0], p0, 0, 0, 0);
        p1 = __builtin_amdgcn_mfma_f32_32x32x16_bf16(b1, qr[d0], p1, 0, 0, 0); }
}
template <int VB, bool SK>
__device__ __forceinline__ void pv_tile(f32x16* o, int vb0, bf16x8 pa0, bf16x8 pa1, bf16x8 pa2, bf16x8 pa3, bool act) {
    if (SK && !act) return;
#define TRRD(dst, off) asm volatile("ds_read_b64_tr_b16 %0, %1 offset:%2" : "=&v"(dst) : "v"(vb0), "i"(off) : "memory")
#define PV_D0(d0) do { s16x4 l0, l1, l2, l3, h0, h1, h2, h3; constexpr int b_ = VB * SHM_V + v_rd_off(d0, 0, 0);     \
        TRRD(l0, b_); TRRD(h0, b_ + 2048); TRRD(l1, b_ + 4096); TRRD(h1, b_ + 6144); TRRD(l2, b_ + 8192); TRRD(h2, b_ + 10240); TRRD(l3, b_ + 12288); TRRD(h3, b_ + 14336); \
        asm volatile("s_waitcnt lgkmcnt(0)" ::: "memory"); SBAR();                 \
        o[d0] = __builtin_amdgcn_mfma_f32_32x32x16_bf16(pa0, (bf16x8){l0[0], l0[1], l0[2], l0[3], h0[0], h0[1], h0[2], h0[3]}, o[d0], 0, 0, 0);   \
        o[d0] = __builtin_amdgcn_mfma_f32_32x32x16_bf16(pa1, (bf16x8){l1[0], l1[1], l1[2], l1[3], h1[0], h1[1], h1[2], h1[3]}, o[d0], 0, 0, 0);   \
        o[d0] = __builtin_amdgcn_mfma_f32_32x32x16_bf16(pa2, (bf16x8){l2[0], l2[1], l2[2], l2[3], h2[0], h2[1], h2[2], h2[3]}, o[d0], 0, 0, 0);   \
        o[d0] = __builtin_amdgcn_mfma_f32_32x32x16_bf16(pa3, (bf16x8){l3[0], l3[1], l3[2], l3[3], h3[0], h3[1], h3[2], h3[3]}, o[d0], 0, 0, 0); } while (0)
    PV_D0(0); PV_D0(1); PV_D0(2); PV_D0(3);
#undef PV_D0
#undef TRRD
}

template <class TIn, class TOut> struct BlockRef { unsigned Q, K, V, O, F; int P0; };
#define BL128(vo, so) __builtin_bit_cast(bf16x8, __builtin_amdgcn_raw_buffer_load_b128(rs, (int)(vo), (int)(so), 0))
#define BL32F(vo, so) __builtin_bit_cast(float, __builtin_amdgcn_raw_buffer_load_b32(rs, (int)(vo), (int)(so), 0))
template <class TIn> struct Seam {
    bf16x8 qr[8];
    bf16x8 st_v0, st_v1, st_k0, st_k1; float st_f;
};
__device__ __forceinline__ int swa_jlo(int P0, int W) { const int lowk = P0 - W + 1; return lowk > 0 ? lowk / KVBLK : 0; }
#define VMW() asm volatile("s_waitcnt vmcnt(0)" ::: "memory")
#define VMWN(n) asm volatile("s_waitcnt vmcnt(%0)" :: "i"(n) : "memory")
#define SLOAD_H(Kp, Vp, Fp, k0) do { const unsigned so_ = (unsigned)(k0) * (RS * 2); S.st_v0 = BL128(lkv, (Vp) + so_); S.st_v1 = BL128(lkv, (Vp) + so_ + 32 * RS * 2); \
                         S.st_k0 = BL128(lkv, (Kp) + so_); S.st_k1 = BL128(lkv, (Kp) + so_ + 32 * RS * 2); S.st_f = BL32F((tid & 63) * 4, (Fp) + (unsigned)(k0) * 4); } while (0)
#define SWRITE_HK(bf) do { *(bf16x8*)(K_lds + (bf) * SHM_K + kws) = S.st_k0; *(bf16x8*)(K_lds + (bf) * SHM_K + kws + 32 * 256) = S.st_k1; \
                           if (tid < 64) *(float*)(K_lds + 2 * SHM_K + NW * 64 * 4 + (bf) * 256 + tid * 4) = S.st_f * RSCALE; } while (0)
#define SWRITE_HV(bf) do { *(bf16x8*)(V_lds + (bf) * SHM_V + vst0) = S.st_v0; *(bf16x8*)(V_lds + (bf) * SHM_V + vst1) = S.st_v1; } while (0)
#define SWRITE_H(bf) do { SWRITE_HV(bf); SWRITE_HK(bf); } while (0)
template <class TIn, class TOut>
__device__ __forceinline__ void causal_swa_prime(const BlockRef<TIn, TOut>& cur, int W, char* lds, Seam<TIn>& S, __amdgpu_buffer_rsrc_t rs, const int tid_in) {
    constexpr bool F32 = same_t<TIn, float>::v;
    const int tid = tid_in, wid = __builtin_amdgcn_readfirstlane(tid >> 6), lane = tid & 63, r32 = lane & 31, hi = lane >> 5;
    const int sr = tid >> 4, sc = (tid & 15) * 8, kws = KSWZ(sr, sc * 2); char* K_lds = lds + 2 * SHM_V;
    const int lkv = (sr * RS + sc) * 2, lq = ((wid * QBLK + r32) * RS + hi * 8) * 2;
    const int kb0 = swa_jlo(cur.P0, W) * KVBLK;
#pragma unroll
    for (int d0 = 0; d0 < 8; ++d0) S.qr[d0] = BL128(lq + d0 * 32, cur.Q);
    SLOAD_H(cur.K, cur.V, cur.F, kb0); VMW(); SWRITE_HK(0);
    __syncthreads();
}
template <class TIn, class TOut>
__device__ __forceinline__ void causal_swa_block(const BlockRef<TIn, TOut>& cur, const BlockRef<TIn, TOut>& nxt, int skv, int W, char* lds, Seam<TIn>& S, __amdgpu_buffer_rsrc_t rs, const int tid_in) {
    constexpr bool F32 = same_t<TIn, float>::v;
    const int tid = tid_in, wid = __builtin_amdgcn_readfirstlane(tid >> 6), lane = tid & 63, r32 = lane & 31, hi = lane >> 5;
    const int j_lo = swa_jlo(cur.P0, W);
    int j_hi = (cur.P0 + QB - 1) / KVBLK + 1; if (j_hi > skv / KVBLK) j_hi = skv / KVBLK;
    const int NT = j_hi - j_lo;
    const int kbn = swa_jlo(nxt.P0, W) * KVBLK;
    const int qlo = cur.P0 + wid * QBLK, qm = qlo + r32 - 4 * hi;
    char* V_lds = lds; char* K_lds = lds + 2 * SHM_V;
    float* ws = (float*)(lds + 2 * SHM_V + 2 * SHM_K) + wid * 64; float* li_l = ws, * al_l = ws + 32;
    float m_reg = -1e30f, l_reg = 0; f32x16 o[4] = {};
    const int sr = tid >> 4, sc = (tid & 15) * 8, vst0 = v_st(sr, sc), vst1 = v_st(32 + sr, sc), kws = KSWZ(sr, sc * 2);
    const int vb0 = (int)(uintptr_t)V_lds + v_rd_base(lane);
    const unsigned Kh = cur.K, Vh = cur.V, Fh = cur.F;
    const int lkv = (sr * RS + sc) * 2, lq = ((wid * QBLK + r32) * RS + hi * 8) * 2;
    const float fi = BL32F((wid * QBLK + r32) * 4, cur.F + (unsigned)cur.P0 * 4) * RSCALE;
#define RESC(a) do { if (__any((a) < 1.f)) { if (hi == 0) al_l[r32] = (a); asm volatile("s_waitcnt lgkmcnt(0)" ::: "memory");              \
                     for (int d_ = 0; d_ < 4; ++d_) for (int r = 0; r < 16; ++r) o[d_][r] *= al_l[crow(r, hi)]; } } while (0)
#define KBASE(t) ((j_lo + (t)) * KVBLK)
#define ACT(t) (KBASE(t) <= qlo + QBLK - 1 && KBASE(t) + KVBLK - 1 >= qlo - W + 1)
#define MASKT(P0_, P1_, t) do { const int kb_ = KBASE(t); if ((!SK || ACT(t)) && (kb_ + KVBLK - 1 > qlo || kb_ <= qlo + QBLK - 1 - W)) mask_tile(P0_, P1_, qm - kb_, (unsigned)W); } while (0)
    constexpr int NQL = F32 ? 16 : 8;
    constexpr bool SK = WSKIP && !F32;
#define SEAM_K0() do { VMWN(NQL); SWRITE_HK(0); SBAR(); } while (0)
    f32x16 pA0, pA1, pB0, pB1; float mnA, mnB, alA, alB; bf16x8 pa0, pa1, pa2, pa3;
    SWRITE_HV(0); SBAR();
    if (NT > 1) { SLOAD_H(Kh, Vh, Fh, KBASE(1)); }
    SBAR(); qkt<0, SK>(pA0, pA1, K_lds, r32, hi, S.qr, ACT(0), fi);
    MASKT(pA0, pA1, 0); partialSM(pA0, pA1, m_reg, mnA, alA);
    if (NT > 1) { VMW(); SWRITE_H(1); }
    __syncthreads();
#define HALF_STEP(PX0, PX1, mnX, alX, PY0, PY1, alY, t, KB, VB, SB) do {                                                      \
        SBAR(); qkt<KB, SK>(PX0, PX1, K_lds, r32, hi, S.qr, ACT(t), fi);                                         \
        finishSM(PY0, PY1, alY, l_reg, pa0, pa1, pa2, pa3); SBAR();                                                           \
        if ((t) + 1 < NT) { SLOAD_H(Kh, Vh, Fh, KBASE((t) + 1)); SBAR(); }                                                   \
        pv_tile<VB, SK>(o, vb0, pa0, pa1, pa2, pa3, ACT((t) - 1)); MASKT(PX0, PX1, (t)); partialSM(PX0, PX1, m_reg, mnX, alX);                                        \
        __syncthreads();                                                                                                      \
        if ((t) + 1 < NT) { VMW(); SWRITE_H(SB); }                                                                            \
        RESC(alX); __syncthreads(); } while (0)
    for (int t = 1; t + 1 < NT; t += 2) {
        HALF_STEP(pB0, pB1, mnB, alB, pA0, pA1, alA, t, 1, 0, 0);
        HALF_STEP(pA0, pA1, mnA, alA, pB0, pB1, alB, t + 1, 0, 1, 1);
    }
    const bool even = (NT & 1) == 0;
    if (even) { SBAR(); qkt<1, SK>(pB0, pB1, K_lds, r32, hi, S.qr, ACT(NT - 1), fi); SBAR(); }
    { SLOAD_H(nxt.K, nxt.V, nxt.F, kbn); SBAR();
#pragma unroll
        for (int d0 = 0; d0 < 8; ++d0) S.qr[d0] = BL128(lq + d0 * 32, nxt.Q); }
    SBAR();
    finishSM(pA0, pA1, alA, l_reg, pa0, pa1, pa2, pa3); SBAR();
    pv_tile<0, SK>(o, vb0, pa0, pa1, pa2, pa3, ACT(even ? NT - 2 : NT - 1));
    if (even) { MASKT(pB0, pB1, NT - 1); partialSM(pB0, pB1, m_reg, mnB, alB); __syncthreads(); RESC(alB);
        finishSM(pB0, pB1, alB, l_reg, pa0, pa1, pa2, pa3); SBAR(); pv_tile<1, SK>(o, vb0, pa0, pa1, pa2, pa3, ACT(NT - 1)); }
    SBAR(); SEAM_K0();
    if (hi == 0) li_l[r32] = l_reg; asm volatile("s_waitcnt lgkmcnt(0)" ::: "memory");
    float rli[16];
#pragma unroll
    for (int r = 0; r < 16; ++r) rli[r] = __builtin_amdgcn_rcpf(li_l[crow(r, hi)]);
    const int lo_ = ((wid * QBLK + 4 * hi) * OS + r32) * 2;
#pragma unroll
    for (int r = 0; r < 16; ++r) { const unsigned so_ = cur.O + (unsigned)(((r & 3) + 8 * (r >> 2)) * OS * 2);
#pragma unroll
        for (int d0 = 0; d0 < 4; ++d0) { const float v = o[d0][r] * rli[r];
            { const float vn = __builtin_bit_cast(float, __builtin_amdgcn_mov_dpp(__builtin_bit_cast(int, v), 0xB1, 0xf, 0xf, true));
                   if ((r32 & 1) == 0) __builtin_amdgcn_raw_buffer_store_b32(cvtpk(v, vn), rs, lo_ + d0 * 64, (int)so_, 0); } } }
    __syncthreads();
#undef RESC
#undef KBASE
#undef ACT
#undef MASKT
#undef SEAM_K0
#undef HALF_STEP
}
#undef ROW
#undef VMW
#undef VMWN
#undef SLOAD_H
#undef SWRITE_HK
#undef SWRITE_HV
#undef SWRITE_H

}


namespace dec {
using bf16x2 = __attribute__((ext_vector_type(2))) __bf16;
using u32x4  = __attribute__((ext_vector_type(4))) unsigned;
using f32x4  = __attribute__((ext_vector_type(4))) float;
using f32x8  = __attribute__((ext_vector_type(8))) float;
constexpr int GE = 8, GEP = 8, HPL = 2, SPL = (256 - 136) / DB, NGRP = PAST / 16;
constexpr float LOG2E = 1.4426950408889634f, C2 = SCALE * LOG2E;
typedef short s16x4_t __attribute__((ext_vector_type(4)));
typedef unsigned u32x2 __attribute__((ext_vector_type(2)));
__device__ __forceinline__ float dot2(unsigned k, unsigned q, float acc) { return __builtin_amdgcn_fdot2_f32_bf16(__builtin_bit_cast(bf16x2, k), __builtin_bit_cast(bf16x2, q), acc, false); }
__device__ __forceinline__ unsigned cvtpk(float lo, float hi) { unsigned r; asm volatile("v_cvt_pk_bf16_f32 %0, %1, %2" : "=v"(r) : "v"(lo), "v"(hi)); return r; }
template <int CTRL> __device__ __forceinline__ float dpp(float x) { return __builtin_bit_cast(float, __builtin_amdgcn_mov_dpp(__builtin_bit_cast(int, x), CTRL, 0xf, 0xf, true)); }
constexpr int XOR1 = 0xB1, XOR2 = 0x4E, XOR7 = 0x141, XOR8 = 0x128, ROR4 = 0x124;
__device__ __forceinline__ float xrow16_max(float x) {
  auto s = __builtin_amdgcn_permlane16_swap(__float_as_uint(x), __float_as_uint(x), false, false); x = fmaxf(__uint_as_float(s[0]), __uint_as_float(s[1]));
  auto t = __builtin_amdgcn_permlane32_swap(__float_as_uint(x), __float_as_uint(x), false, false); return fmaxf(__uint_as_float(t[0]), __uint_as_float(t[1])); }
__device__ __forceinline__ float xrow16_sum(float x) {
  auto s = __builtin_amdgcn_permlane16_swap(__float_as_uint(x), __float_as_uint(x), false, false); x = __uint_as_float(s[0]) + __uint_as_float(s[1]);
  auto t = __builtin_amdgcn_permlane32_swap(__float_as_uint(x), __float_as_uint(x), false, false); return __uint_as_float(t[0]) + __uint_as_float(t[1]); }
__device__ __forceinline__ u32x4 tobf2(u32x4 a, u32x4 b) { u32x4 w = {cvtpk(__uint_as_float(a[0]), __uint_as_float(a[1])), cvtpk(__uint_as_float(a[2]), __uint_as_float(a[3])), cvtpk(__uint_as_float(b[0]), __uint_as_float(b[1])), cvtpk(__uint_as_float(b[2]), __uint_as_float(b[3]))}; return w; }

__device__ __forceinline__ void split_wave(const P& p, int b, int s, int h, int lane, float* pex  , LAS unsigned char* slot  ) {
  const int r = lane >> 4, c = lane & 15;
  const unsigned short* Qb = (const unsigned short*)(p.ws + WS_QB);
  u32x4* qlds = reinterpret_cast<u32x4*>(pex + 256);
  if (r == 0) {
#pragma unroll
    for (int g = 0; g < GEP; ++g) { const unsigned short* qp = Qb + (size_t)(MP + b * DS + g) * AW + h * HD + 4 * c;
      const u32x2 q0 = *reinterpret_cast<const u32x2*>(qp), q1 = *reinterpret_cast<const u32x2*>(qp + 64); qlds[g * 16 + c] = (u32x4){q0.x, q0.y, q1.x, q1.y}; }
  }
  asm volatile("s_waitcnt vmcnt(0) lgkmcnt(0)" ::: "memory");
  const int gbeg = (s * NGRP) / SPL, gend = ((s + 1) * NGRP) / SPL, pg0 = gbeg >> 3;
  int btv = 0; if (lane < 16) { const int pgi = pg0 + lane; btv = p.pt[b * NPG + (pgi < NPG ? pgi : NPG - 1)]; }
  const __amdgpu_buffer_rsrc_t rk = __builtin_amdgcn_make_buffer_rsrc((void*)p.ck, (short)0, 0x7fffffff, 0x00020000), rv = __builtin_amdgcn_make_buffer_rsrc((void*)p.cv, (short)0, 0x7fffffff, 0x00020000);
  const __amdgpu_buffer_rsrc_t rw = __builtin_amdgcn_make_buffer_rsrc((void*)p.ws, (short)0, 0x7fffffff, 0x00020000);
  const int lo4 = (r * AW + h * HD + 4 * c) * 4;
  const int ld4 = (r + 4 * (c >> 2)) * 4; const int dbase = (int)WS_DEC + ((b * NH + h) * PAST) * 4;
#define GOFF(i_) const int phys_ = __builtin_amdgcn_readlane(btv, ((i_) >> 3) - pg0); const int so_ = phys_ * (PAGE * AW * 4) + ((i_) & 7) * (16 * AW * 4)
#define DISSUE(i_) do { GOFF(i_); \
    dn = __builtin_bit_cast(float, __builtin_amdgcn_raw_buffer_load_b32(rw, ld4, dbase + (i_) * 64, 0)); \
    _Pragma("unroll") for (int t_ = 0; t_ < 4; ++t_) { Kn[t_][0] = __builtin_amdgcn_raw_buffer_load_b128(rk, lo4, so_ + t_ * (4 * AW * 4), 2); Kn[t_][1] = __builtin_amdgcn_raw_buffer_load_b128(rk, lo4 + 256, so_ + t_ * (4 * AW * 4), 2); \
                                                      Vn[t_][0] = __builtin_amdgcn_raw_buffer_load_b128(rv, lo4, so_ + t_ * (4 * AW * 4), 2); Vn[t_][1] = __builtin_amdgcn_raw_buffer_load_b128(rv, lo4 + 256, so_ + t_ * (4 * AW * 4), 2); } } while (0)
#define DMAISSUE(i_) do { GOFF(i_); \
    dn2 = __builtin_bit_cast(float, __builtin_amdgcn_raw_buffer_load_b32(rw, ld4, dbase + (i_) * 64, 0)); \
    _Pragma("unroll") for (int t_ = 0; t_ < 4; ++t_) _Pragma("unroll") for (int hf_ = 0; hf_ < 2; ++hf_) { \
        __builtin_amdgcn_raw_ptr_buffer_load_lds(rk, (LAS void*)(slot + (t_ * 2 + hf_) * 1024), 16, lo4 + 256 * hf_, so_ + t_ * (4 * AW * 4), 0, 2); \
        __builtin_amdgcn_raw_ptr_buffer_load_lds(rv, (LAS void*)(slot + 8192 + (t_ * 2 + hf_) * 1024), 16, lo4 + 256 * hf_, so_ + t_ * (4 * AW * 4), 0, 2); } } while (0)
  u32x4 Kn[4][2], Vn[4][2]; float dn, dn2 = 0.f;
  float m[HPL], l[HPL]; f32x4 accm[8];
#pragma unroll
  for (int j = 0; j < HPL; ++j) { m[j] = -INFINITY; l[j] = 0.f; }
#pragma unroll
  for (int k = 0; k < 8; ++k) accm[k] = (f32x4){0.f, 0.f, 0.f, 0.f};
  auto math = [&](const u32x4 (&Kc)[4], const u32x2 (&Vb)[8], const float dcur) {
    float x[4 * GEP];
#pragma unroll
    for (int g = 0; g < GEP; ++g) { const u32x4 qg = qlds[g * 16 + c];
#pragma unroll
      for (int t = 0; t < 4; ++t) { float d = 0.f;
#pragma unroll
        for (int k = 0; k < 4; ++k) d = dot2(Kc[t][k], qg[k], d);
        x[t * GEP + g] = d; } }
#define TR_STEP(HALF, CTRL, BIT) _Pragma("unroll") for (int hh = 0; hh < (HALF); ++hh) _Pragma("unroll") for (int j = 0; j < HPL; ++j) { \
      const float lo_ = x[hh * HPL + j], hi_ = x[(hh + (HALF)) * HPL + j]; const float t1_ = lo_ + dpp<CTRL>(lo_), t2_ = hi_ + dpp<CTRL>(hi_); \
      x[hh * HPL + j] = (c & (BIT)) ? t2_ : t1_; }
    TR_STEP(8, XOR8, 8) TR_STEP(4, XOR7, 4) TR_STEP(2, XOR2, 2) TR_STEP(1, XOR1, 1)
#undef TR_STEP
    float pj[HPL], alpha[HPL];
#pragma unroll
    for (int j = 0; j < HPL; ++j) {
      const float sc = fmaf(x[j], C2, dcur);
      float pm = sc; pm = fmaxf(pm, dpp<ROR4>(pm)); pm = fmaxf(pm, dpp<XOR8>(pm)); pm = xrow16_max(pm);
      const float mn = fmaxf(m[j], pm), msub = (mn == -INFINITY) ? 0.f : mn;
      alpha[j] = __builtin_amdgcn_exp2f(m[j] - msub); pj[j] = __builtin_amdgcn_exp2f(sc - msub);
      l[j] = fmaf(l[j], alpha[j], pj[j]); m[j] = mn;
    }
#pragma unroll
    for (int j = 0; j < HPL; ++j) pex[(r * 8 + 2 * (c & 3) + j) * 4 + (c >> 2)] = pj[j];
    if (lane < 4) { pex[128 + 2 * lane] = alpha[0]; pex[128 + 2 * lane + 1] = alpha[1]; }
    asm volatile("s_waitcnt lgkmcnt(0)" ::: "memory");
    const f32x4 pa = *reinterpret_cast<const f32x4*>(pex + (r * 8 + (c & 7)) * 4);
    const f32x4 av = *reinterpret_cast<const f32x4*>(pex + 128 + 4 * (r & 1));
    asm volatile("s_waitcnt lgkmcnt(0)" ::: "memory");
    u32x2 pa16; pa16.x = cvtpk(pa[0], pa[1]); pa16.y = cvtpk(pa[2], pa[3]);
    if (c >= 8) { pa16.x = 0u; pa16.y = 0u; }
#pragma unroll
    for (int e = 0; e < 8; ++e) { accm[e] = accm[e] * av;
      accm[e] = __builtin_amdgcn_mfma_f32_16x16x16bf16_1k(__builtin_bit_cast(s16x4_t, pa16), __builtin_bit_cast(s16x4_t, Vb[e]), accm[e], 0, 0, 0); }
  };
  DISSUE(gbeg);
  if (gbeg + 1 < gend) DMAISSUE(gbeg + 1);
  for (int i = gbeg; i < gend; i += 2) {
    { u32x4 Kc[4]; u32x2 Vb[8];
#pragma unroll
      for (int t = 0; t < 4; ++t) Kc[t] = tobf2(Kn[t][0], Kn[t][1]);
#pragma unroll
      for (int e = 0; e < 8; ++e) { Vb[e].x = cvtpk(__uint_as_float(Vn[0][e >> 2][e & 3]), __uint_as_float(Vn[1][e >> 2][e & 3])); Vb[e].y = cvtpk(__uint_as_float(Vn[2][e >> 2][e & 3]), __uint_as_float(Vn[3][e >> 2][e & 3])); }
      const float dcur = dn * LOG2E;
      if (i + 2 < gend) DISSUE(i + 2);
      math(Kc, Vb, dcur); }
    if (i + 1 < gend) { u32x4 Kc[4]; u32x2 Vb[8];
      const float dcur = dn2 * LOG2E;
      if (i + 2 < gend) asm volatile("s_waitcnt vmcnt(17)" ::: "memory"); else asm volatile("s_waitcnt vmcnt(0)" ::: "memory");
      u32x4 Vr[4][2];
#pragma unroll
      for (int t = 0; t < 4; ++t) { const LAS u32x4* kp = (const LAS u32x4*)(slot + (t * 2) * 1024) + lane; const LAS u32x4* vp = (const LAS u32x4*)(slot + 8192 + (t * 2) * 1024) + lane;
        Kc[t] = tobf2(kp[0], kp[64]); Vr[t][0] = vp[0]; Vr[t][1] = vp[64]; }
#pragma unroll
      for (int e = 0; e < 8; ++e) { Vb[e].x = cvtpk(__uint_as_float(Vr[0][e >> 2][e & 3]), __uint_as_float(Vr[1][e >> 2][e & 3])); Vb[e].y = cvtpk(__uint_as_float(Vr[2][e >> 2][e & 3]), __uint_as_float(Vr[3][e >> 2][e & 3])); }
      asm volatile("s_waitcnt lgkmcnt(0)" ::: "memory");
      if (i + 3 < gend) DMAISSUE(i + 3);
      math(Kc, Vb, dcur); }
  }
#undef DISSUE
#undef DMAISSUE
#undef GOFF
#pragma unroll
  for (int j = 0; j < HPL; ++j) { float t = l[j]; t += dpp<ROR4>(t); t += dpp<XOR8>(t); l[j] = xrow16_sum(t); }
  float* po = (float*)(p.ws + WS_PO); float* pml = (float*)(p.ws + WS_PML);
  if (r < 2) {
#pragma unroll
    for (int i = 0; i < 4; ++i) { const size_t slot_ = (size_t)(((b * NH + h) * DS + 4 * r + i) * SPL + s);
      *reinterpret_cast<f32x4*>(po + slot_ * HD + 4 * c) = f32x4{accm[0][i], accm[1][i], accm[2][i], accm[3][i]};
      *reinterpret_cast<f32x4*>(po + slot_ * HD + 64 + 4 * c) = f32x4{accm[4][i], accm[5][i], accm[6][i], accm[7][i]}; } }
  if (r == 0) {
#pragma unroll
    for (int g = 0; g < GE; ++g) { const size_t slot_ = (size_t)(((b * NH + h) * DS + g) * SPL + s);
      if (c == g / HPL) { pml[2 * slot_] = m[g % HPL]; pml[2 * slot_ + 1] = l[g % HPL]; } } }
}
__device__ __forceinline__ void combine_row(const P& p, int row, int lane) {
  const int b = row >> 6, h = (row >> 3) & 7, q = row & 7, d0 = 2 * lane;
  const unsigned short* Qb = (const unsigned short*)(p.ws + WS_QB); const unsigned short* Kb = (const unsigned short*)(p.ws + WS_KB); const unsigned short* Vb = (const unsigned short*)(p.ws + WS_VB);
  const float* LF = (const float*)(p.ws + WS_LF); const float* po = (const float*)(p.ws + WS_PO); const float* pml = (const float*)(p.ws + WS_PML);
  const unsigned qw = *reinterpret_cast<const unsigned*>(Qb + (size_t)(MP + b * DS + q) * AW + h * HD + d0);
  const float q0 = __builtin_bit_cast(float, qw << 16), q1 = __builtin_bit_cast(float, qw & 0xffff0000u);
  float s2[DS], v0[DS], v1[DS]; float fsum = 0.f;
#pragma unroll
  for (int j = 0; j < DS; ++j) {
    fsum += LF[(size_t)(MP + b * DS + j) * NH + h];
    const unsigned kw = *reinterpret_cast<const unsigned*>(Kb + (size_t)(MP + b * DS + j) * AW + h * HD + d0);
    const unsigned vw = *reinterpret_cast<const unsigned*>(Vb + (size_t)(MP + b * DS + j) * AW + h * HD + d0);
    v0[j] = __builtin_bit_cast(float, vw << 16); v1[j] = __builtin_bit_cast(float, vw & 0xffff0000u);
    const float dt = wave_sum(q0 * __builtin_bit_cast(float, kw << 16) + q1 * __builtin_bit_cast(float, kw & 0xffff0000u));
    s2[j] = (j <= q) ? dt * C2 - fsum * LOG2E : -INFINITY;
  }
  const size_t slot0 = (size_t)row * SPL;
  float Mx = -INFINITY;
#pragma unroll
  for (int s = 0; s < SPL; ++s) Mx = fmaxf(Mx, pml[2 * (slot0 + s)]);
#pragma unroll
  for (int j = 0; j < DS; ++j) Mx = fmaxf(Mx, s2[j]);
  float L = 0.f, o0 = 0.f, o1 = 0.f;
#pragma unroll
  for (int s = 0; s < SPL; ++s) { const float ls = pml[2 * (slot0 + s) + 1], w = (ls > 0.f) ? __builtin_amdgcn_exp2f(pml[2 * (slot0 + s)] - Mx) : 0.f;
    const float2 a = *reinterpret_cast<const float2*>(po + (slot0 + s) * HD + d0); L = fmaf(w, ls, L); o0 = fmaf(w, a.x, o0); o1 = fmaf(w, a.y, o1); }
#pragma unroll
  for (int j = 0; j < DS; ++j) { const float pj = __builtin_amdgcn_exp2f(s2[j] - Mx); L += pj; o0 = fmaf(pj, v0[j], o0); o1 = fmaf(pj, v1[j], o1); }
  const float inv = 1.f / L;
  *reinterpret_cast<unsigned*>((unsigned short*)(p.ws + WS_ASB) + (size_t)(MP + b * DS + q) * D + h * HD + d0) = pk2(o0 * inv, o1 * inv);
}
}
constexpr int ATT_NP = 136, ATT_MAXB = 2;
__device__ const short ATT_SCHED[ATT_NP][ATT_MAXB] = {
  {255,-1},
  {239,-1},
  {223,-1},
  {207,-1},
  {191,-1},
  {175,-1},
  {159,-1},
  {143,-1},
  {127,-1},
  {111,-1},
  {95,-1},
  {79,-1},
  {63,-1},
  {47,-1},
  {31,-1},
  {15,-1},
  {254,240},
  {238,224},
  {222,208},
  {206,192},
  {190,176},
  {174,160},
  {158,144},
  {142,128},
  {126,112},
  {110,96},
  {94,80},
  {78,64},
  {62,48},
  {46,32},
  {30,16},
  {14,0},
  {253,241},
  {237,225},
  {221,209},
  {205,193},
  {189,177},
  {173,161},
  {157,145},
  {141,129},
  {125,113},
  {109,97},
  {93,81},
  {77,65},
  {61,49},
  {45,33},
  {29,17},
  {13,1},
  {252,242},
  {236,226},
  {220,210},
  {204,194},
  {188,178},
  {172,162},
  {156,146},
  {140,130},
  {124,114},
  {108,98},
  {92,82},
  {76,66},
  {60,50},
  {44,34},
  {28,18},
  {12,2},
  {251,243},
  {235,227},
  {219,211},
  {203,195},
  {187,179},
  {171,163},
  {155,147},
  {139,131},
  {123,115},
  {107,99},
  {91,83},
  {75,67},
  {59,51},
  {43,35},
  {27,19},
  {11,3},
  {250,244},
  {234,228},
  {218,212},
  {202,196},
  {186,180},
  {170,164},
  {154,148},
  {138,132},
  {122,116},
  {106,100},
  {90,84},
  {74,68},
  {58,52},
  {42,36},
  {26,20},
  {10,4},
  {249,245},
  {233,229},
  {217,213},
  {201,197},
  {185,181},
  {169,165},
  {153,149},
  {137,133},
  {121,117},
  {105,101},
  {89,85},
  {73,69},
  {57,53},
  {41,37},
  {25,21},
  {9,5},
  {248,246},
  {232,230},
  {216,214},
  {200,198},
  {184,182},
  {168,166},
  {152,150},
  {136,134},
  {120,118},
  {104,102},
  {88,86},
  {72,70},
  {56,54},
  {40,38},
  {24,22},
  {8,6},
  {247,119},
  {231,103},
  {215,87},
  {199,71},
  {183,55},
  {167,39},
  {151,23},
  {135,7}
};
__device__ __forceinline__ void phase_attn_prompt(const P& p, char* lds, int wg, const int tid) {
    typedef att::BlockRef<att::bf16, att::bf16> BR;
    const __amdgpu_buffer_rsrc_t rs = __builtin_amdgcn_make_buffer_rsrc((void*)p.ws, (short)0, 0x7fffffff, 0x00020000);
    constexpr int NQB = SEQ / att::QB;
    constexpr int W = 1 << 30;
    auto mk = [&](int id) { const int bh = id / NQB, qb = id % NQB, b = bh / NH, h = bh % NH; const unsigned row0 = (unsigned)(b * SEQ + qb * att::QB);
        BR r; r.Q = (unsigned)WS_QB + (row0 * att::RS + h * HD) * 2u; r.O = (unsigned)WS_ASB + (row0 * att::OS + h * HD) * 2u;
        r.K = (unsigned)WS_KB + ((unsigned)(b * SEQ) * att::RS + h * HD) * 2u; r.V = (unsigned)WS_VB + ((unsigned)(b * SEQ) * att::RS + h * HD) * 2u;
        r.F = (unsigned)WS_FC + (unsigned)(bh * SEQ) * 4u; r.P0 = qb * att::QB; return r; };
    int slot = 0;
    BR cur = mk(ATT_SCHED[wg][0]);
    att::Seam<att::bf16> S;
    att::causal_swa_prime<att::bf16, att::bf16>(cur, W, lds, S, rs, tid);
    for (;;) {
        const int nid = (slot + 1 < ATT_MAXB) ? (int)ATT_SCHED[wg][slot + 1] : -1;
        const bool last = nid < 0;
        const BR nxt = last ? cur : mk(nid);
        att::causal_swa_block<att::bf16, att::bf16>(cur, nxt, SEQ, W, lds, S, rs, tid);
        if (last) break;
        cur = nxt; ++slot;
    }
}
__global__ void __launch_bounds__(NWAVES * 64, 2) mega(P p) {
#define LOADP() do { int l_; asm volatile("v_mbcnt_lo_u32_b32 %0, -1, 0\n\tv_mbcnt_hi_u32_b32 %0, -1, %0" : "=v"(l_)); F.lane = l_; F.tid = F.wave * 64 + l_; } while (0)
    extern __shared__ __attribute__((aligned(16))) unsigned char lds[];
    Frame F;
    F.lds = (LAS unsigned char*)lds; F.tid = threadIdx.x; F.lane = F.tid & 63; F.wave = __builtin_amdgcn_readfirstlane(F.tid >> 6); F.G = gridDim.x; F.bid = blockIdx.x;
    volatile LAS unsigned* MISC = (volatile LAS unsigned*)(F.lds + MISC_OFF);
    for (int u = F.tid; u < (LDS_BYTES - LDSCTL_OFF) / 4; u += NWAVES * 64) ((LAS unsigned*)(F.lds + LDSCTL_OFF))[u] = 0u;
    __syncthreads();
    XcdBarrier bar = xcd_barrier_post((unsigned*)p.ws + CW_BAR, MISC + 8, F.tid);
#ifndef PHMASK
#define PHMASK 0xFFFF
#endif
#define IN(k) ((PHMASK >> (k)) & 1)
#define BOTH(k) (IN(k) && IN((k) + 1))
    if (IN(0)) { LOADP(); p0_prologue(p, F); __syncthreads(); }
    if (IN(1)) { LOADP(); phase_l0(p, F, bar.bar); if (BOTH(1)) xcd_barrier(bar, F.tid); }
    if (IN(2)) { LOADP();
        if (F.bid < NB * NH) scan_fc(p, F, F.bid);
        { SEpi1 E{&p}; skinny_gemm<4>(F, (const bf16*)(p.ws + WS_HB) + (size_t)MP * D, (const bf16*)(p.ws + WS_W1T), N1, D, (unsigned*)p.ws + CW_SK + 0 * 1024, p.ws, WS_SPART, E); }
        pg8::Gemm g{(const bf16*)(p.ws + WS_HB), (const bf16*)(p.ws + WS_W1T), MP, N1, D}; pg8::StaticOrder S; S.init(MP, N1, F.G, F.bid);
        pg8::EpiQKVU E{(bf16*)(p.ws + WS_QB), (bf16*)(p.ws + WS_KB), (bf16*)(p.ws + WS_VB), (bf16*)(p.ws + WS_UB), p.out + O_KP, p.out + O_VP, nullptr, nullptr};
        pg8::gemm_phase<pg8::EpiQKVU, pg8::StaticOrder, true, true>(F.lds + RING_OFF, g, S, E, F.tid);
        if (BOTH(2)) xcd_barrier(bar, F.tid);
    }
    if (IN(3)) { LOADP();
        if (F.G == 256) { ssm::Tab T; const int g = (F.bid * NWAVES + F.wave) % NG; ssm::load_tab<false>(p, g, F.lane, T);
            for (int u = F.bid * NWAVES + F.wave; u < NG * ssm::NCH; u += F.G * NWAVES) ssm::unit<0>(p, T, g, u / NG, F.lane, F.lds); }
        VM_WAIT(); __syncthreads();
        if (F.tid == 0) { __builtin_amdgcn_fence(__ATOMIC_RELEASE, "agent"); VM_WAIT(); (void)xb_add((unsigned*)p.ws + CW_SSMA, 1u); }
        if (F.G == 256) {
            if (F.bid < ATT_NP) {
                phase_attn_prompt(p, (char*)lds, F.bid, F.tid);
                LOADP();
                if (F.tid == 0) { XB_SPIN(xb_ld((unsigned*)p.ws + CW_SSMA) < (unsigned)F.G, bar.bar); __builtin_amdgcn_fence(__ATOMIC_ACQUIRE, "agent"); VM_WAIT(); }
                __syncthreads();
                LAS unsigned char* img = F.lds + F.wave * ssm::WIMG;
                static_assert((ATT_NP * NWAVES) % NG == 0, "a wave's S5 units must share one group");
                ssm::Tab T; const int g = (F.bid * NWAVES + F.wave) % NG; ssm::load_tab<true>(p, g, F.lane, T);
                for (int u = F.bid * NWAVES + F.wave; u < NG * ssm::NCH + NG * (DB / 2); u += ATT_NP * NWAVES) {
                    if (u < NG * ssm::NCH) ssm::unit<1>(p, T, g, u / NG, F.lane, img);
                    else ssm::unit<2>(p, T, g, (u - NG * ssm::NCH) / NG, F.lane, img); }
            } else { const int idx = F.bid - ATT_NP; dec::split_wave(p, idx / dec::SPL, idx % dec::SPL, F.wave, F.lane, (float*)(lds + DEC_PEX_OFF) + F.wave * 768, F.lds + F.wave * 16384); }
        }
        if (BOTH(3)) xcd_barrier(bar, F.tid);
    }
    if (IN(4)) { LOADP();
        for (int row = F.bid * NWAVES + F.wave; row < DB * NH * DS; row += F.G * NWAVES) dec::combine_row(p, row, F.lane);
        if (BOTH(4)) xcd_barrier(bar, F.tid);
    }
    if (IN(5)) { LOADP();
        const bf16* ASB = (const bf16*)(p.ws + WS_ASB);
        { SEpiRes<true> E{&p, p.xs, 2}; skinny_gemm<2>(F, ASB + (size_t)MP * D, (const bf16*)(p.ws + WS_W2T), D, D, (unsigned*)p.ws + CW_SK + 1 * 1024, p.ws, WS_SPART, E); }
        pg8::Gemm g{ASB, (const bf16*)(p.ws + WS_W2T), MP, D, D}; pg8::StaticOrder S; S.init(MP, D, F.G, F.bid);
        pg8::EpiRes<true> E{p.xp, modp(p, 0, 2), (bf16*)(p.ws + WS_T)};
        pg8::gemm_phase<pg8::EpiRes<true>, pg8::StaticOrder, false, true>(F.lds + RING_OFF, g, S, E, F.tid);
        if (BOTH(5)) xcd_barrier(bar, F.tid);
    }
    if (IN(6)) { LOADP(); phase_l1(p, F); if (BOTH(6)) xcd_barrier(bar, F.tid); }
    if (IN(7)) { LOADP();
        { SEpiRelu2 E{&p}; skinny_gemm<8>(F, (const bf16*)(p.ws + WS_HB) + (size_t)MP * D, (const bf16*)(p.ws + WS_W3T), DFF, D, (unsigned*)p.ws + CW_SK + 2 * 1024, p.ws, WS_SPART, E); }
        pg8::Gemm g{(const bf16*)(p.ws + WS_HB), (const bf16*)(p.ws + WS_W3T), MP, DFF, D}; pg8::StaticOrder S; S.init(MP, DFF, F.G, F.bid);
        pg8::EpiRelu2 E{(bf16*)(p.ws + WS_AB), DFF};
        pg8::gemm_phase<pg8::EpiRelu2, pg8::StaticOrder, true, true>(F.lds + RING_OFF, g, S, E, F.tid);
        if (BOTH(7)) xcd_barrier(bar, F.tid);
    }
    if (IN(8)) { LOADP();
        const bf16* AB = (const bf16*)(p.ws + WS_AB); const bf16* X1 = (const bf16*)(p.ws + WS_X1);
        { SEpiRes<false> E{&p, X1 + (size_t)MP * D, 5}; skinny_gemm<8>(F, AB + (size_t)MP * DFF, (const bf16*)(p.ws + WS_W4T), D, DFF, (unsigned*)p.ws + CW_SK + 3 * 1024, p.ws, WS_SPART, E); }
        pg8::Gemm g{AB, (const bf16*)(p.ws + WS_W4T), MP, D, DFF}; pg8::StaticOrder S; S.init(MP, D, F.G, F.bid);
        pg8::EpiRes<false> E{X1, modp(p, 0, 5), (bf16*)(p.ws + WS_T)};
        pg8::gemm_phase<pg8::EpiRes<false>, pg8::StaticOrder, false, true>(F.lds + RING_OFF, g, S, E, F.tid);
        if (BOTH(8)) xcd_barrier(bar, F.tid);
    }
    if (IN(9)) { LOADP(); phase_l2(p, F); }
#undef IN
#undef BOTH
}
extern "C" void kernel_launch(void* const* d_in, const int* in_sizes, int n_in, void* d_out, int out_size, void* d_ws, size_t ws_size, hipStream_t stream) {
    static int grid = 0;
    if (grid == 0) {
        if (n_in != 31 || out_size != (int)O_END || ws_size < WS_END) { fprintf(stderr, "kernel_launch: unexpected shapes\n"); grid = -1; return; }
        int dev = 0, cus = 0;
        if (hipGetDevice(&dev) != hipSuccess || hipDeviceGetAttribute(&cus, hipDeviceAttributeMultiprocessorCount, dev) != hipSuccess) { grid = -1; return; }
        if (hipFuncSetAttribute((const void*)mega, hipFuncAttributeMaxDynamicSharedMemorySize, LDS_BYTES) != hipSuccess) { fprintf(stderr, "kernel_launch: hipFuncSetAttribute failed\n"); grid = -1; return; }
        int per_cu = 0; (void)hipOccupancyMaxActiveBlocksPerMultiprocessor(&per_cu, (const void*)mega, NWAVES * 64, LDS_BYTES); (void)hipGetLastError();
        if (cus != 256) fprintf(stderr, "kernel_launch: the phase programme is dealt for 256 CUs (device reports %d)\n", cus);
        grid = 256;
    }
    if (grid < 0) return;
    P p{};
    p.xp = (const float*)d_in[0]; p.xs = (const float*)d_in[1]; p.cp = (const float*)d_in[2]; p.cs = (const float*)d_in[3];
    p.ck = (const float*)d_in[4]; p.cv = (const float*)d_in[5]; p.clf = (const float*)d_in[6]; p.sre = (const float*)d_in[7]; p.sim = (const float*)d_in[8];
    p.pt = (const int*)d_in[9]; p.w_ada = (const float*)d_in[10]; p.b_ada = (const float*)d_in[11]; p.w_in = (const float*)d_in[12]; p.b_f = (const float*)d_in[13];
    p.w_o = (const float*)d_in[14]; p.a_re = (const float*)d_in[15]; p.a_im = (const float*)d_in[16]; p.log_dt = (const float*)d_in[17];
    p.b_re = (const float*)d_in[18]; p.b_im = (const float*)d_in[19]; p.c_re = (const float*)d_in[20]; p.c_im = (const float*)d_in[21];
    p.d_skip = (const float*)d_in[22]; p.w_glu = (const float*)d_in[23]; p.b_glu = (const float*)d_in[24]; p.ln1_g = (const float*)d_in[25]; p.ln1_b = (const float*)d_in[26];
    p.w_up = (const float*)d_in[27]; p.w_down = (const float*)d_in[28]; p.ln2_g = (const float*)d_in[29]; p.ln2_b = (const float*)d_in[30];
    p.out = (float*)d_out; p.ws = (unsigned char*)d_ws;
    (void)hipMemsetAsync((char*)d_ws + WS_CTL, 0, CTL_ZERO_BYTES, stream);
    p.ph_lo = 0; p.ph_hi = 10; p.li = 0; p.pad = 0;
    hipLaunchKernelGGL(mega, dim3(grid), dim3(NWAVES * 64), LDS_BYTES, stream, p);
    (void)in_sizes;
}
```

```cpp
#include <hip/hip_runtime.h>
#include <cstdint>
#include <cstdio>
#include <cmath>

constexpr int D = 2048, NB = 2, SEQ = 4096, DB = 8, DS = 8, PAST = 16384, PAGE = 128, NPG = PAST / PAGE;
constexpr int AW = 1024, SW = 1024, HD = 128, NH = 8, SG = 16, NG = 64, SP = 64, DFF = 8192, NMOD = 6;
constexpr int INC = 3 * AW + NH + SW;
constexpr int MP = NB * SEQ, MS = DB * DS, M = MP + MS;
constexpr int NBT = NB + DB;
constexpr int N1 = 3 * AW + SW;
constexpr float ALPHA = 1.189207115002721f;
constexpr float LN_EPS = 1e-5f;
constexpr float SCALE = 0.08838834764831845f;
constexpr size_t O_YP = 0, O_YS = O_YP + (size_t)MP * D, O_KP = O_YS + (size_t)MS * D, O_VP = O_KP + (size_t)MP * AW,
                 O_LFP = O_VP + (size_t)MP * AW, O_SRP = O_LFP + (size_t)MP * NH, O_SIP = O_SRP + NB * NG * SP,
                 O_KS = O_SIP + NB * NG * SP, O_VS = O_KS + (size_t)MS * AW, O_LFS = O_VS + (size_t)MS * AW,
                 O_SRS = O_LFS + MS * NH, O_SIS = O_SRS + DB * NG * SP, O_END = O_SIS + DB * NG * SP;
constexpr size_t MiB = 1u << 20;
constexpr size_t WS_CTL = 0, CTL_ZERO_BYTES = 1 * MiB;
constexpr size_t WS_MOD = 1 * MiB;
constexpr size_t WS_W1T = 2 * MiB;
constexpr size_t WS_W2T = 18 * MiB;
constexpr size_t WS_W3T = 26 * MiB;
constexpr size_t WS_W4T = 58 * MiB;
constexpr size_t WS_HB  = 90 * MiB;
constexpr size_t WS_QB  = 124 * MiB;
constexpr size_t WS_KB  = 141 * MiB;
constexpr size_t WS_VB  = 158 * MiB;
constexpr size_t WS_UB  = 175 * MiB;
constexpr size_t WS_LF  = 192 * MiB;
constexpr size_t WS_FC  = 193 * MiB;
constexpr size_t WS_DEC = 194 * MiB;
constexpr size_t WS_ASB = 199 * MiB;
constexpr size_t WS_T   = 233 * MiB;
constexpr size_t WS_X1  = 298 * MiB;
constexpr size_t WS_AB  = 363 * MiB;
constexpr size_t WS_Q   = 493 * MiB;
constexpr size_t WS_U   = 527 * MiB;
constexpr size_t WS_AS  = 561 * MiB;
constexpr size_t WS_SC  = 626 * MiB;
constexpr size_t WS_PO  = 660 * MiB;
constexpr size_t WS_PML = 665 * MiB;
constexpr size_t WS_LAM = 666 * MiB;
constexpr size_t WS_BB  = 667 * MiB;
constexpr size_t WS_CC  = 668 * MiB;
constexpr size_t WS_WG  = 669 * MiB;
constexpr size_t WS_SEND = 670 * MiB;
constexpr size_t WS_PART = 700 * MiB;
constexpr size_t WS_SPART = 704 * MiB;
constexpr size_t WS_END = 712 * MiB;

static_assert(WS_KB - WS_QB == 17 * MiB && WS_VB - WS_KB == 17 * MiB && WS_UB - WS_VB == 17 * MiB && WS_U - WS_Q == 34 * MiB && O_VP - O_KP == (size_t)MP * AW, "EpiQKVU pointer arithmetic");
struct P {
    const float *xp, *xs, *cp, *cs, *ck, *cv, *clf, *sre, *sim; const int* pt;
    const float *w_ada, *b_ada, *w_in, *b_f, *w_o, *a_re, *a_im, *log_dt, *b_re, *b_im, *c_re, *c_im, *d_skip, *w_glu, *b_glu,
                *ln1_g, *ln1_b, *w_up, *w_down, *ln2_g, *ln2_b;
    float* out; unsigned char* ws;
    int ph_lo, ph_hi, li, pad;
};
__device__ __forceinline__ const float* xrow(const P& p, int m) { return m < MP ? p.xp + (size_t)m * D : p.xs + (size_t)(m - MP) * D; }
__device__ __forceinline__ int brow(int m) { return m < MP ? m / SEQ : NB + (m - MP) / DS; }
__device__ __forceinline__ float* modp(const P& p, int b, int i) { return (float*)(p.ws + WS_MOD) + (size_t)b * NMOD * D + (size_t)i * D; }
__device__ __forceinline__ float log_sigmoid(float x) { return fminf(x, 0.f) - log1pf(__expf(-fabsf(x))); }

namespace pg8 {
#define PG8_LAS __attribute__((address_space(3)))
typedef unsigned short bf16_t;
typedef short bf16x8 __attribute__((ext_vector_type(8)));
typedef float f32x4 __attribute__((ext_vector_type(4)));
typedef unsigned u32x4 __attribute__((ext_vector_type(4)));
constexpr int BM = 256, BK = 64, HALF = 128, HTB = HALF * BK * 2  , STAGE_BYTES = 8 * HTB, NXCD = 8, WGM = 8;

__host__ __device__ __forceinline__ int lds_byte(int r, int c) { const int st = (r >> 4) * 2 + (c >> 5), rr = r & 15, cc = c & 31, ob = rr * 64 + cc * 2; return st * 1024 + (ob ^ (((ob >> 9) & 1) << 5)); }
__host__ __device__ __forceinline__ void stage_rc(int b, int& R, int& C) { const int st = b / 1024, sb = b % 1024, swz = sb ^ (((sb >> 9) & 1) << 5); R = (st >> 1) * 16 + swz / 64; C = (st & 1) * 32 + (swz % 64) / 2; }
__host__ __device__ __forceinline__ int perm32(int rho) { const int n = rho >> 4, i = rho & 15; return 8 * (i >> 2) + 4 * n + (i & 3); }

struct Unit { int pm, pn; };
struct Gemm { const bf16_t* A; const bf16_t* Bt; int M, N, K; };

struct StaticOrder {
    int nM, nN, nwg, G, c;
    __host__ __device__ void init(int M, int N, int G_, int c_) { nM = M / BM; nN = N / BM; nwg = nM * nN; G = G_; c = c_; }
    __host__ __device__ bool next(int i, Unit& u) const {
        const long L = (long)i * G + c; if (L >= nwg) return false;
        int wgid = (int)L; { const int q = nwg / NXCD, r = nwg % NXCD, xcd = wgid % NXCD, off = wgid / NXCD; wgid = (xcd < r ? xcd * (q + 1) : r * (q + 1) + (xcd - r) * q) + off; }
        const int nig = WGM * nN, gid = wgid / nig, fm = gid * WGM, gsz = (nM - fm) < WGM ? (nM - fm) : WGM;
        u.pm = fm + ((wgid % nig) % gsz); u.pn = (wgid % nig) / gsz; return true;
    }
    __device__ __forceinline__ void a_ready(const Unit&) const {}
    __device__ __forceinline__ void done(const Unit&) const {}
};

__device__ __forceinline__ unsigned cvt_pk_bf16(float lo, float hi) { unsigned r; asm volatile("v_cvt_pk_bf16_f32 %0, %1, %2" : "=v"(r) : "v"(lo), "v"(hi)); return r; }
typedef float f32x2 __attribute__((ext_vector_type(2)));
struct EpiQKVU {
    static constexpr bool PERM = true, AFTER_DRAIN = false;
    bf16_t *Qb, *Kb, *Vb, *Ub; float *outK, *outV; float *Qf, *Uf;
    __device__ __forceinline__ void operator()(const f32x4 (&acc)[2][2][4][2], const Unit& u, int wr, int wc, int fr, int fq) const {
        const int region = u.pn >> 2, colt = (u.pn & 3) * BM;
        const int row0 = u.pm * BM + wr * 64 + fr, col0 = colt + wc * 32 + 8 * fq;
        bf16_t* ob = Qb + (size_t)region * (17u << 19);
        float* of = (region == 1 || region == 2) ? outK + (size_t)(region - 1) * ((size_t)8192 * 1024) : (Qf ? Qf + (size_t)(region / 3) * (34u << 18) : nullptr);
#pragma unroll
        for (int ai = 0; ai < 2; ++ai)
#pragma unroll
            for (int m = 0; m < 4; ++m) { const size_t ro = (size_t)(row0 + ai * HALF + m * 16) * 1024 + col0;
#pragma unroll
                for (int bj = 0; bj < 2; ++bj) { const f32x4 v0 = acc[ai][bj][m][0], v1 = acc[ai][bj][m][1];
                    u32x4 w; w.x = cvt_pk_bf16(v0[0], v0[1]); w.y = cvt_pk_bf16(v0[2], v0[3]); w.z = cvt_pk_bf16(v1[0], v1[1]); w.w = cvt_pk_bf16(v1[2], v1[3]);
                    *(u32x4*)(ob + ro + bj * HALF) = w;
                    if (of) { __builtin_nontemporal_store(v0, (f32x4*)(of + ro + bj * HALF)); __builtin_nontemporal_store(v1, (f32x4*)(of + ro + bj * HALF + 4)); } } }
    }
};
template <bool BASE_F32> struct EpiRes {
    static constexpr bool PERM = true, AFTER_DRAIN = false;
    const void* base; const float* gate0; bf16_t* T;
    __device__ __forceinline__ void operator()(const f32x4 (&acc)[2][2][4][2], const Unit& u, int wr, int wc, int fr, int fq) const {
        const int row0 = u.pm * BM + wr * 64 + fr, col0 = u.pn * BM + wc * 32 + 8 * fq;
        const float* gb = gate0 + (size_t)((u.pm * BM) / 4096) * (6 * 2048);
#pragma unroll
        for (int bj = 0; bj < 2; ++bj) { const int col = col0 + bj * HALF; const f32x4 g0 = *(const f32x4*)(gb + col) + 1.0f, g1 = *(const f32x4*)(gb + col + 4) + 1.0f;
#pragma unroll
            for (int ai = 0; ai < 2; ++ai)
#pragma unroll
                for (int m = 0; m < 4; ++m) { const size_t off = (size_t)(row0 + ai * HALF + m * 16) * 2048 + col;
                    f32x4 b0, b1;
                    if (BASE_F32) { b0 = *(const f32x4*)((const float*)base + off); b1 = *(const f32x4*)((const float*)base + off + 4); }
                    else { const u32x4 w = *(const u32x4*)((const bf16_t*)base + off);
                        b0 = (f32x4){__builtin_bit_cast(float, w.x << 16), __builtin_bit_cast(float, w.x & 0xffff0000u), __builtin_bit_cast(float, w.y << 16), __builtin_bit_cast(float, w.y & 0xffff0000u)};
                        b1 = (f32x4){__builtin_bit_cast(float, w.z << 16), __builtin_bit_cast(float, w.z & 0xffff0000u), __builtin_bit_cast(float, w.w << 16), __builtin_bit_cast(float, w.w & 0xffff0000u)}; }
                    const f32x4 t0 = b0 * 1.189207115002721f + g0 * acc[ai][bj][m][0], t1 = b1 * 1.189207115002721f + g1 * acc[ai][bj][m][1];
                    u32x4 o; o.x = cvt_pk_bf16(t0[0], t0[1]); o.y = cvt_pk_bf16(t0[2], t0[3]); o.z = cvt_pk_bf16(t1[0], t1[1]); o.w = cvt_pk_bf16(t1[2], t1[3]);
                    *(u32x4*)(T + off) = o; } }
    }
};
struct EpiRelu2 {
    static constexpr bool PERM = true, AFTER_DRAIN = false;
    bf16_t* O; int ldc;
    __device__ __forceinline__ void operator()(const f32x4 (&acc)[2][2][4][2], const Unit& u, int wr, int wc, int fr, int fq) const {
        const int row0 = u.pm * BM + wr * 64 + fr, col0 = u.pn * BM + wc * 32 + 8 * fq;
#pragma unroll
        for (int ai = 0; ai < 2; ++ai)
#pragma unroll
            for (int m = 0; m < 4; ++m) { bf16_t* rowp = O + (size_t)(row0 + ai * HALF + m * 16) * ldc + col0;
#pragma unroll
                for (int bj = 0; bj < 2; ++bj) { f32x4 v0 = acc[ai][bj][m][0], v1 = acc[ai][bj][m][1];
                    v0 = __builtin_elementwise_max(v0, (f32x4){0.f, 0.f, 0.f, 0.f}); v1 = __builtin_elementwise_max(v1, (f32x4){0.f, 0.f, 0.f, 0.f}); v0 = v0 * v0; v1 = v1 * v1;
                    u32x4 w; w.x = cvt_pk_bf16(v0[0], v0[1]); w.y = cvt_pk_bf16(v0[2], v0[3]); w.z = cvt_pk_bf16(v1[0], v1[1]); w.w = cvt_pk_bf16(v1[2], v1[3]);
                    *(u32x4*)(rowp + bj * HALF) = w; } }
    }
};
template <class Epi, class Sched, bool ALIGN_EPI = false, bool SP2 = false>
__device__ __forceinline__ void gemm_phase(PG8_LAS unsigned char* lds, const Gemm g, const Sched& S, const Epi& E, const int tid_in) {
    const int tid = tid_in, wid = __builtin_amdgcn_readfirstlane(tid >> 6), lane = tid & 63, wr = wid >> 2, wc = wid & 3, fr = lane & 15, fq = lane >> 4;
    const int K = g.K, nt = K / BK;
    unsigned voffA[2], voffB[2];
#pragma unroll
    for (int i = 0; i < 2; ++i) { int R, C; stage_rc(tid * 16 + i * 8192, R, C); const int Rb = Epi::PERM ? ((R & ~31) + perm32(R & 31)) : R;
        voffA[i] = (unsigned)(R * K + C) * 2u; voffB[i] = (unsigned)(Rb * K + C) * 2u; }
    const size_t kstep = (size_t)(BK * 2);
    const size_t hstep = (size_t)HALF * K * 2;
    const size_t tstep = 2 * hstep;
    const unsigned ldsw = (unsigned)wid * 1024u;
    const int aoff = lds_byte(wr * 64 + fr, fq * 8), boff = lds_byte(wc * 32 + fr, fq * 8);
#define PG8_SA(b, h) (((b) * 2 + (h)) * HTB)
#define PG8_SB(b, h) ((4 + (b) * 2 + (h)) * HTB)
#define PG8_STAGE(bufoff, gbase, voff) do { _Pragma("unroll") for (int _i = 0; _i < 2; ++_i) \
        __builtin_amdgcn_global_load_lds((const unsigned*)((const char*)(gbase) + (voff)[_i]), (PG8_LAS unsigned*)(lds + (bufoff) + ldsw + _i * 8192), 16, 0, 0); } while (0)
#define PG8_LDA(dst, b, h) do { _Pragma("unroll") for (int m = 0; m < 4; ++m) _Pragma("unroll") for (int k = 0; k < 2; ++k) dst[m][k] = *(const PG8_LAS bf16x8*)(lds + PG8_SA(b, h) + aoff + m * 2048 + k * 1024); } while (0)
#define PG8_LDB(dst, b, h) do { _Pragma("unroll") for (int n = 0; n < 2; ++n) _Pragma("unroll") for (int k = 0; k < 2; ++k) dst[n][k] = *(const PG8_LAS bf16x8*)(lds + PG8_SB(b, h) + boff + n * 2048 + k * 1024); } while (0)
#define PG8_MMA(ai, bj, At, Bt) do { __builtin_amdgcn_s_setprio(1); _Pragma("unroll") for (int m = 0; m < 4; ++m) _Pragma("unroll") for (int n = 0; n < 2; ++n) _Pragma("unroll") for (int k = 0; k < 2; ++k) \
        acc[ai][bj][m][n] = __builtin_amdgcn_mfma_f32_16x16x32_bf16(Bt[n][k], At[m][k], acc[ai][bj][m][n], 0, 0, 0); __builtin_amdgcn_s_setprio(0); } while (0)
#define PG8_WAIT_V(n) asm volatile("s_waitcnt vmcnt(" #n ")" ::: "memory")
#define PG8_WAIT_L(n) asm volatile("s_waitcnt lgkmcnt(" #n ")" ::: "memory")
#define PG8_BAR __builtin_amdgcn_s_barrier()
#define PG8_SCHED __builtin_amdgcn_sched_barrier(0)
    Unit cur, nxt; int ui = 0;
    if (!S.next(0, cur)) return;
    f32x4 acc[2][2][4][2];
#pragma unroll
    for (int a = 0; a < 2; ++a)
#pragma unroll
        for (int b = 0; b < 2; ++b)
#pragma unroll
            for (int m = 0; m < 4; ++m)
#pragma unroll
                for (int n = 0; n < 2; ++n) acc[a][b][m][n] = (f32x4){0.f, 0.f, 0.f, 0.f};
    bf16x8 At[4][2], B0[2][2], B1[2][2];
    const char* cA = (const char*)g.A + (size_t)cur.pm * tstep; const char* cB = (const char*)g.Bt + (size_t)cur.pn * tstep;
    S.a_ready(cur);
    if constexpr (SP2) {
        PG8_STAGE(PG8_SB(0, 0), cB, voffB); PG8_STAGE(PG8_SB(0, 1), cB + hstep, voffB); PG8_STAGE(PG8_SA(0, 0), cA, voffA); PG8_STAGE(PG8_SA(0, 1), cA + hstep, voffA);
        if (wr == 1) PG8_BAR;
        PG8_WAIT_V(2); PG8_BAR;
        PG8_STAGE(PG8_SB(1, 0), cB + kstep, voffB); PG8_STAGE(PG8_SA(1, 0), cA + kstep, voffA); PG8_STAGE(PG8_SB(1, 1), cB + hstep + kstep, voffB);
        PG8_WAIT_V(6); PG8_BAR;
    } else {
        PG8_STAGE(PG8_SB(0, 0), cB, voffB); PG8_STAGE(PG8_SA(0, 0), cA, voffA); PG8_STAGE(PG8_SB(0, 1), cB + hstep, voffB); PG8_STAGE(PG8_SA(0, 1), cA + hstep, voffA);
        if (wr == 1) PG8_BAR;
        PG8_WAIT_V(4); PG8_BAR;
        PG8_STAGE(PG8_SB(1, 0), cB + kstep, voffB); PG8_STAGE(PG8_SA(1, 0), cA + kstep, voffA); PG8_STAGE(PG8_SB(1, 1), cB + hstep + kstep, voffB);
        PG8_WAIT_V(6); PG8_BAR;
    }
    for (;;) {
        const bool has_next = S.next(ui + 1, nxt);
        const char* nA = has_next ? (const char*)g.A + (size_t)nxt.pm * tstep : cA; const char* nB = has_next ? (const char*)g.Bt + (size_t)nxt.pn * tstep : cB;
        for (int t = 0; t < nt; t += 2) {
            const bool last = (t == nt - 2);
            const char* a1 = cA + (size_t)(t + 1) * kstep;
            const char* a2 = last ? nA : cA + (size_t)(t + 2) * kstep; const char* b2 = last ? nB : cB + (size_t)(t + 2) * kstep;
            const char* a3 = a2 + kstep; const char* b3 = b2 + kstep;
            if (last && has_next) S.a_ready(nxt);
            if constexpr (SP2) {
            PG8_LDB(B0, 0, 0); PG8_LDB(B1, 0, 1); PG8_SCHED; PG8_LDA(At, 0, 0); PG8_STAGE(PG8_SA(1, 1), a1 + hstep, voffA);
            PG8_WAIT_V(8); PG8_WAIT_L(0); PG8_BAR; PG8_MMA(0, 0, At, B0); PG8_MMA(0, 1, At, B1); PG8_BAR; PG8_SCHED;
            PG8_LDA(At, 0, 1); PG8_STAGE(PG8_SB(0, 0), b2, voffB); PG8_STAGE(PG8_SB(0, 1), b2 + hstep, voffB); PG8_STAGE(PG8_SA(0, 0), a2, voffA);
            PG8_WAIT_V(8); PG8_WAIT_L(0); PG8_BAR; PG8_MMA(1, 0, At, B0); PG8_MMA(1, 1, At, B1); PG8_BAR; PG8_SCHED;
            PG8_LDB(B0, 1, 0); PG8_LDB(B1, 1, 1); PG8_SCHED; PG8_LDA(At, 1, 0); PG8_STAGE(PG8_SA(0, 1), a2 + hstep, voffA);
            PG8_WAIT_V(8); PG8_WAIT_L(0); PG8_BAR; PG8_MMA(0, 0, At, B0); PG8_MMA(0, 1, At, B1); PG8_BAR; PG8_SCHED;
            PG8_LDA(At, 1, 1); PG8_STAGE(PG8_SB(1, 0), b3, voffB); PG8_STAGE(PG8_SB(1, 1), b3 + hstep, voffB); PG8_STAGE(PG8_SA(1, 0), a3, voffA);
            PG8_WAIT_V(8); PG8_WAIT_L(0); PG8_BAR; PG8_MMA(1, 0, At, B0); PG8_MMA(1, 1, At, B1); PG8_BAR; PG8_SCHED;
            } else {
            PG8_LDB(B0, 0, 0); PG8_SCHED; PG8_LDA(At, 0, 0); PG8_STAGE(PG8_SA(1, 1), a1 + hstep, voffA);
            PG8_WAIT_L(8); PG8_BAR; PG8_WAIT_L(0); PG8_MMA(0, 0, At, B0); PG8_BAR; PG8_SCHED;
            PG8_LDB(B1, 0, 1); PG8_STAGE(PG8_SB(0, 0), b2, voffB);
            PG8_BAR; PG8_WAIT_L(0); PG8_MMA(0, 1, At, B1); PG8_BAR;
            PG8_LDA(At, 0, 1); PG8_STAGE(PG8_SA(0, 0), a2, voffA);
            PG8_BAR; PG8_WAIT_L(0); PG8_MMA(1, 0, At, B0); PG8_BAR; PG8_SCHED;
            PG8_STAGE(PG8_SB(0, 1), b2 + hstep, voffB);
            PG8_WAIT_V(6); PG8_BAR; PG8_MMA(1, 1, At, B1); PG8_BAR;
            PG8_LDB(B0, 1, 0); PG8_SCHED; PG8_LDA(At, 1, 0); PG8_STAGE(PG8_SA(0, 1), a2 + hstep, voffA);
            PG8_WAIT_L(8); PG8_BAR; PG8_WAIT_L(0); PG8_MMA(0, 0, At, B0); PG8_BAR; PG8_SCHED;
            PG8_LDB(B1, 1, 1); PG8_STAGE(PG8_SB(1, 0), b3, voffB);
            PG8_BAR; PG8_WAIT_L(0); PG8_MMA(0, 1, At, B1); PG8_BAR;
            PG8_LDA(At, 1, 1); PG8_STAGE(PG8_SA(1, 0), a3, voffA);
            PG8_BAR; PG8_WAIT_L(0); PG8_MMA(1, 0, At, B0); PG8_BAR; PG8_SCHED;
            PG8_STAGE(PG8_SB(1, 1), b3 + hstep, voffB);
            PG8_WAIT_V(6); PG8_BAR; PG8_MMA(1, 1, At, B1); PG8_BAR;
            }
        }
        if constexpr (ALIGN_EPI) { if (wr == 0) PG8_BAR; }
        if constexpr (!Epi::AFTER_DRAIN) { E(acc, cur, wr, wc, fr, fq); S.done(cur); }
        if (!has_next) break;
#pragma unroll
        for (int a = 0; a < 2; ++a)
#pragma unroll
            for (int b = 0; b < 2; ++b)
#pragma unroll
                for (int m = 0; m < 4; ++m)
#pragma unroll
                    for (int n = 0; n < 2; ++n) acc[a][b][m][n] = (f32x4){0.f, 0.f, 0.f, 0.f};
        cur = nxt; cA = nA; cB = nB; ++ui;
        if constexpr (ALIGN_EPI) { if (wr == 1) PG8_BAR; }
    }
    PG8_WAIT_V(0);
    if constexpr (!ALIGN_EPI) { if (wr == 0) PG8_BAR; }
    PG8_BAR;
    if constexpr (Epi::AFTER_DRAIN) { E.fused(acc, cur, wr, wc, fr, fq, lds, wid, lane); S.done(cur); }
#undef PG8_SA
#undef PG8_SB
#undef PG8_STAGE
#undef PG8_LDA
#undef PG8_LDB
#undef PG8_MMA
#undef PG8_WAIT_V
#undef PG8_WAIT_L
#undef PG8_BAR
#undef PG8_SCHED
}
}
constexpr int NWAVES = 8;
constexpr int RING_OFF = 0, RING_BYTES = 131072;
constexpr int LDSCTL_OFF = RING_BYTES, MISC_OFF = LDSCTL_OFF + 320;
constexpr int LDS_BYTES = 163840;
constexpr int DEC_PEX_OFF = 132096;
constexpr int CW_TMO = 0, CW_CODE = 1, CW_MOD = 1024, CW_SSMA = 2048, CW_BAR = 4096, CW_SK = 16384;

#define GAS __attribute__((address_space(1)))
#define LAS __attribute__((address_space(3)))
typedef unsigned short bf16;
typedef unsigned v4u __attribute__((ext_vector_type(4)));
typedef unsigned v2u __attribute__((ext_vector_type(2)));
typedef float f32x4 __attribute__((ext_vector_type(4)));
typedef float f32x2 __attribute__((ext_vector_type(2)));
typedef short bf16x8 __attribute__((ext_vector_type(8)));
typedef GAS unsigned gu32;
#define RLX_AGENT __ATOMIC_RELAXED, __HIP_MEMORY_SCOPE_AGENT
#define LDS_WAIT() asm volatile("s_waitcnt lgkmcnt(0)" ::: "memory")
#define VM_WAIT() asm volatile("s_waitcnt vmcnt(0)" ::: "memory")
__device__ __forceinline__ unsigned f2bf(float f) { unsigned u = __builtin_bit_cast(unsigned, f); return (u + 0x7fffu + ((u >> 16) & 1u)) >> 16; }
typedef __bf16 pk_bf16x2 __attribute__((ext_vector_type(2)));
__device__ __forceinline__ unsigned pk2(float lo, float hi) { f32x2 v = {lo, hi}; return __builtin_bit_cast(unsigned, __builtin_convertvector(v, pk_bf16x2)); }
template <int CTRL> __device__ __forceinline__ float dpp_mov(float x) { return __builtin_bit_cast(float, __builtin_amdgcn_mov_dpp(__builtin_bit_cast(int, x), CTRL, 0xf, 0xf, true)); }
__device__ __forceinline__ float rows_sum(float x) {
    auto s = __builtin_amdgcn_permlane16_swap(__float_as_uint(x), __float_as_uint(x), false, false); x = __uint_as_float(s[0]) + __uint_as_float(s[1]);
    auto t = __builtin_amdgcn_permlane32_swap(__float_as_uint(x), __float_as_uint(x), false, false); return __uint_as_float(t[0]) + __uint_as_float(t[1]); }
__device__ __forceinline__ float wave_sum(float v) {
    v += dpp_mov<0xB1>(v);
    v += dpp_mov<0x4E>(v);
    v += dpp_mov<0x141>(v);
    v += dpp_mov<0x128>(v);
    return rows_sum(v);
}
#define XB_TMO      128
#define XB_XCNT(j)  (256  + 64 * (j))
#define XB_XSUB(j)  (1280 + 64 * (j))
#define XB_XGEN(j)  (2304 + 64 * (j))
#define XB_TOP      3328
#define XB_TOPGEN   3392
#define XCD_BAR_WORDS 3456
#define XB_SPIN_CAP (1u << 18)

__device__ __forceinline__ unsigned xb_ld(unsigned* p)              { return __hip_atomic_load(p, __ATOMIC_RELAXED, __HIP_MEMORY_SCOPE_AGENT); }
__device__ __forceinline__ unsigned xb_add(unsigned* p, unsigned v) { return __hip_atomic_fetch_add(p, v, __ATOMIC_RELAXED, __HIP_MEMORY_SCOPE_AGENT); }
__device__ __forceinline__ unsigned xb_xcc_id() { return (unsigned)__builtin_amdgcn_s_getreg((3 << 11) | 20) & 0xFu; }
#define XB_SPIN(cond, bar) do { unsigned _sp = 0; while (cond) { __builtin_amdgcn_s_sleep(1); \
    if ((++_sp & 255u) == 0u) { if (xb_ld(&(bar)[XB_TMO])) break; if (_sp > XB_SPIN_CAP) { atomicAdd(&(bar)[XB_TMO], 1u); break; } } } } while (0)

struct XcdBarrier {
    unsigned* bar; unsigned x;
    volatile LAS unsigned* st;
};

__device__ __forceinline__ XcdBarrier xcd_barrier_post(unsigned* bar, volatile LAS unsigned* st, const int tid) {
    XcdBarrier b; b.bar = bar; b.x = xb_xcc_id(); b.st = st;
    if (tid == 0) (void)xb_add(&bar[XB_XCNT(b.x)], 1u);
    return b;
}
__device__ __forceinline__ void xcd_barrier_complete(unsigned* bar, unsigned x, unsigned& nloc, unsigned& nx) {
    const unsigned G = gridDim.x * gridDim.y * gridDim.z;
    unsigned sum, cnt, mine, sp = 0u;
    for (;;) {
        sum = 0u; cnt = 0u; mine = 0u;
#pragma unroll
        for (unsigned j = 0; j < 16; ++j) { const unsigned c = xb_ld(&bar[XB_XCNT(j)]); sum += c; cnt += (c > 0u) ? 1u : 0u; mine = (j == x) ? c : mine; }
        if (sum == G) break;
        __builtin_amdgcn_s_sleep(1);
        if ((++sp & 255u) == 0u) { if (xb_ld(&bar[XB_TMO])) break; if (sp > XB_SPIN_CAP) { atomicAdd(&bar[XB_TMO], 1u); break; } }
    }
    nloc = mine > 0u ? mine : 1u; nx = cnt > 0u ? cnt : 1u;
}

__device__ __forceinline__ void xcd_barrier(const XcdBarrier& b, const int tid) {
    asm volatile("s_waitcnt vmcnt(0)" ::: "memory");
    __syncthreads();
    if (tid == 0) {
        unsigned* bar = b.bar;
        __builtin_amdgcn_s_waitcnt(0);
        unsigned nloc = b.st[0], nx = b.st[1];
        if (nloc == 0u) { xcd_barrier_complete(bar, b.x, nloc, nx); b.st[0] = nloc; b.st[1] = nx; }
        const unsigned old = xb_add(&bar[XB_XSUB(b.x)], 1u);
        const unsigned gen = old / nloc;
        if (old + 1u == (gen + 1u) * nloc) {
            __builtin_amdgcn_fence(__ATOMIC_RELEASE, "agent");
            asm volatile("s_waitcnt vmcnt(0)" ::: "memory");
            const unsigned og = xb_add(&bar[XB_TOP], 1u);
            const unsigned tg = og / nx;
            if (og + 1u == (tg + 1u) * nx) xb_add(&bar[XB_TOPGEN], 1u);
            else XB_SPIN(xb_ld(&bar[XB_TOPGEN]) == tg, bar);
            __builtin_amdgcn_fence(__ATOMIC_ACQUIRE, "agent");
            xb_add(&bar[XB_XGEN(b.x)], 1u);
            asm volatile("s_waitcnt vmcnt(0)" ::: "memory");
        } else {
            XB_SPIN(xb_ld(&bar[XB_XGEN(b.x)]) == gen, bar);
            __builtin_amdgcn_fence(__ATOMIC_ACQUIRE, "agent");
            asm volatile("s_waitcnt vmcnt(0)" ::: "memory");
        }
    }
    __syncthreads();
}


struct Frame { LAS unsigned char* lds; int tid, lane, wave, G, bid; };

namespace ssm {
typedef short bf16x8 __attribute__((ext_vector_type(8)));
typedef short s16x4 __attribute__((ext_vector_type(4)));
typedef float f32x16 __attribute__((ext_vector_type(16)));
typedef float f32x4 __attribute__((ext_vector_type(4)));
typedef float f32x2 __attribute__((ext_vector_type(2)));
typedef __bf16 bf16x2_t __attribute__((ext_vector_type(2)));
typedef unsigned u32x4 __attribute__((ext_vector_type(4)));
typedef unsigned u32x2 __attribute__((ext_vector_type(2)));
typedef short v4i16_t __attribute__((ext_vector_type(4)));
constexpr int CH = 64, NCH = SEQ / CH;
constexpr int ROWB = 72, IMGB = 32 * ROWB, WIMG = 4 * IMGB;
#define MFMA32(a, b, c) __builtin_amdgcn_mfma_f32_32x32x16_bf16((a), (b), (c), 0, 0, 0)
__device__ __forceinline__ unsigned cvtpk_s(float lo, float hi) { f32x2 v = {lo, hi}; bf16x2_t b = __builtin_convertvector(v, bf16x2_t); return __builtin_bit_cast(unsigned, b); }
__device__ __forceinline__ float bf_lo(unsigned w) { return __builtin_bit_cast(float, w << 16); }
__device__ __forceinline__ float bf_hi(unsigned w) { return __builtin_bit_cast(float, w & 0xffff0000u); }
__device__ __forceinline__ float gelu_tanh_f(float x) { const float a = 1.5957691216057308f * (x + 0.044715f * x * x * x); return x / (1.f + __expf(-a)); }

__device__ __forceinline__ void build_tables(const P& p, int g, int lane) {
    float* LAM = (float*)(p.ws + WS_LAM) + (size_t)g * 128; unsigned short* BB = (unsigned short*)(p.ws + WS_BB) + (size_t)g * 128 * 16;
    unsigned short* CC = (unsigned short*)(p.ws + WS_CC) + (size_t)g * 16 * 128; unsigned short* WG = (unsigned short*)(p.ws + WS_WG) + (size_t)g * 512;
    const float are = p.a_re[g * SP + lane], aim = p.a_im[g * SP + lane], dt = expf(p.log_dt[g]);
    const float mag = expf(are * dt), lr = mag * cosf(aim * dt), li = mag * sinf(aim * dt);
    const float den = are * are + aim * aim, nre = lr - 1.f;
    const float kre = (nre * are + li * aim) / den, kim = (li * are - nre * aim) / den;
    LAM[lane] = lr; LAM[64 + lane] = li;
#pragma unroll
    for (int c = 0; c < SG; c += 2) {
        const float br0 = p.b_re[(size_t)(g * SP + lane) * SG + c], bi0 = p.b_im[(size_t)(g * SP + lane) * SG + c], br1 = p.b_re[(size_t)(g * SP + lane) * SG + c + 1], bi1 = p.b_im[(size_t)(g * SP + lane) * SG + c + 1];
        *(unsigned*)(BB + (size_t)lane * 16 + c) = pk2(kre * br0 - kim * bi0, kre * br1 - kim * bi1);
        *(unsigned*)(BB + (size_t)(64 + lane) * 16 + c) = pk2(kre * bi0 + kim * br0, kre * bi1 + kim * br1);
    }
#pragma unroll
    for (int co = 0; co < SG; ++co) { CC[co * 128 + lane] = (unsigned short)f2bf(p.c_re[(size_t)(g * SG + co) * SP + lane]); CC[co * 128 + 64 + lane] = (unsigned short)f2bf(-p.c_im[(size_t)(g * SG + co) * SP + lane]); }
#pragma unroll
    for (int i = 0; i < 8; ++i) { const int idx = lane * 8 + i, j = idx & 7, e = (idx >> 3) & 31, h = idx >> 8, co = 8 * (j >> 2) + 4 * h + (j & 3);
        WG[idx] = (unsigned short)f2bf(p.w_glu[(size_t)(g * SG + co) * 2 * SG + e]); }
}
struct Tab { float lr[2], li[2]; bf16x8 bfrag[4]; bf16x8 ccfrag[8]; bf16x8 wgfrag; f32x4 dsk[2], bgv[2], bgg[2]; };
template <bool OUT>
__device__ __forceinline__ void load_tab(const P& p, int g, int lane, Tab& T) {
    const int c32 = lane & 31, hi = lane >> 5;
    const float* LAM = (const float*)(p.ws + WS_LAM) + (size_t)g * 128; const unsigned short* BB = (const unsigned short*)(p.ws + WS_BB) + (size_t)g * 128 * 16;
#pragma unroll
    for (int pb = 0; pb < 2; ++pb) { T.lr[pb] = LAM[c32 + 32 * pb]; T.li[pb] = LAM[64 + c32 + 32 * pb]; }
#pragma unroll
    for (int cb = 0; cb < 4; ++cb) T.bfrag[cb] = *(const bf16x8*)(BB + (size_t)(32 * cb + c32) * 16 + 8 * hi);
    if (OUT) {
        const unsigned short* CC = (const unsigned short*)(p.ws + WS_CC) + (size_t)g * 16 * 128; const unsigned short* WG = (const unsigned short*)(p.ws + WS_WG) + (size_t)g * 512;
#pragma unroll
        for (int s = 0; s < 8; ++s) { bf16x8 v = {0, 0, 0, 0, 0, 0, 0, 0}; if (c32 < 16) v = *(const bf16x8*)(CC + (size_t)c32 * 128 + 16 * s + 8 * hi); T.ccfrag[s] = v; }
        T.wgfrag = *(const bf16x8*)(WG + (size_t)(hi * 32 + c32) * 8);
#pragma unroll
        for (int q = 0; q < 2; ++q) { T.dsk[q] = *(const f32x4*)(p.d_skip + g * SG + 8 * q + 4 * hi); T.bgv[q] = *(const f32x4*)(p.b_glu + g * 2 * SG + 8 * q + 4 * hi); T.bgg[q] = *(const f32x4*)(p.b_glu + g * 2 * SG + SG + 8 * q + 4 * hi); }
    }
}
template <int MODE>
__device__ __forceinline__ void unit(const P& p, const Tab& T, int g, int cidx  , int lane, LAS unsigned char* img) {
    const int c32 = lane & 31, hi = lane >> 5;
    const unsigned short* Ub = (const unsigned short*)(p.ws + WS_UB);
    float hr[2], hm[2];
    const float (&lr)[2] = T.lr; const float (&li)[2] = T.li; const bf16x8 (&bfrag)[4] = T.bfrag;
#pragma unroll
    for (int pb = 0; pb < 2; ++pb) { hr[pb] = 0.f; hm[pb] = 0.f; }
    const int th = (c32 >> 2) & 1, tr = (c32 & 3) + 4 * (c32 >> 3);
    int rbA, rbD;
    if (MODE == 2) { rbA = MP + (cidx + 4 * th) * DS; rbD = MP + (cidx + 4 * hi) * DS; } else { rbA = th * SEQ + cidx * CH; rbD = hi * SEQ + cidx * CH; }
    if (MODE == 1 && cidx > 0) {
        float pr[2], pi[2];
#pragma unroll
        for (int pb = 0; pb < 2; ++pb) { float a = lr[pb], b = li[pb];
#pragma unroll
            for (int k = 0; k < 6; ++k) { const float na = a * a - b * b, nb = 2.f * a * b; a = na; b = nb; }
            pr[pb] = a; pi[pb] = b; }
        const float* S = (const float*)(p.ws + WS_SEND) + ((size_t)(hi * NG + g) * NCH) * 128 + c32;
        for (int j0 = 0; j0 < cidx; j0 += 8) {
            float sv[8][4];
#pragma unroll
            for (int jj = 0; jj < 8; ++jj) { const int j = (j0 + jj < cidx) ? j0 + jj : cidx - 1;
#pragma unroll
                for (int pb = 0; pb < 2; ++pb) { sv[jj][pb] = S[(size_t)j * 128 + 32 * pb]; sv[jj][2 + pb] = S[(size_t)j * 128 + 64 + 32 * pb]; } }
#pragma unroll
            for (int jj = 0; jj < 8; ++jj) if (j0 + jj < cidx) {
#pragma unroll
                for (int pb = 0; pb < 2; ++pb) { const float nr = pr[pb] * hr[pb] - pi[pb] * hm[pb] + sv[jj][pb], ni = pr[pb] * hm[pb] + pi[pb] * hr[pb] + sv[jj][2 + pb]; hr[pb] = nr; hm[pb] = ni; } }
        }
    }
    if (MODE == 2) {
#pragma unroll
        for (int pb = 0; pb < 2; ++pb) { hr[pb] = p.sre[(size_t)((cidx + 4 * hi) * NG + g) * SP + c32 + 32 * pb]; hm[pb] = p.sim[(size_t)((cidx + 4 * hi) * NG + g) * SP + c32 + 32 * pb]; }
    }
    const bf16x8 (&ccfrag)[8] = T.ccfrag; const bf16x8& wgfrag = T.wgfrag; const f32x4 (&dsk)[2] = T.dsk; const f32x4 (&bgv)[2] = T.bgv; const f32x4 (&bgg)[2] = T.bgg;
    float fr[2] = {0.f, 0.f}, fm[2] = {0.f, 0.f};
    constexpr int NSB = MODE == 2 ? 1 : CH / 16;
    const int trA = MODE == 2 ? (tr < DS ? tr : DS - 1) : tr;
    bf16x8 afn = *(const bf16x8*)(Ub + (size_t)(rbA + trA) * SW + g * SG + 8 * hi);
    u32x2 u0n = {0u, 0u}, u1n = {0u, 0u};
    if (MODE != 0) { u0n = *(const u32x2*)(Ub + (size_t)(rbA + trA) * SW + g * SG + 4 * hi); u1n = *(const u32x2*)(Ub + (size_t)(rbA + trA) * SW + g * SG + 8 + 4 * hi); }
    for (int sb = 0; sb < NSB; ++sb) {
        const bf16x8 afrag = afn; const u32x2 u0 = u0n, u1 = u1n;
        if (sb + 1 < NSB) { const size_t rn = (size_t)(rbA + 16 * (sb + 1) + trA) * SW + g * SG; afn = *(const bf16x8*)(Ub + rn + 8 * hi);
            if (MODE != 0) { u0n = *(const u32x2*)(Ub + rn + 4 * hi); u1n = *(const u32x2*)(Ub + rn + 8 + 4 * hi); } }
        const f32x16 zero = {0.f, 0.f, 0.f, 0.f, 0.f, 0.f, 0.f, 0.f, 0.f, 0.f, 0.f, 0.f, 0.f, 0.f, 0.f, 0.f};
        f32x16 bu[4];
#pragma unroll
        for (int cb = 0; cb < 4; ++cb) bu[cb] = MFMA32(afrag, bfrag[cb], zero);
#pragma unroll
        for (int r = 0; r < 16; ++r) {
#pragma unroll
            for (int pb = 0; pb < 2; ++pb) { const float nr = lr[pb] * hr[pb] - li[pb] * hm[pb] + bu[pb][r], ni = lr[pb] * hm[pb] + li[pb] * hr[pb] + bu[2 + pb][r];
                hr[pb] = nr; hm[pb] = ni; bu[pb][r] = nr; bu[2 + pb][r] = ni; }
            if (MODE == 2 && r == DS - 1) { fr[0] = hr[0]; fr[1] = hr[1]; fm[0] = hm[0]; fm[1] = hm[1]; }
        }
        if (MODE == 0) continue;
#pragma unroll
        for (int cb = 0; cb < 4; ++cb)
#pragma unroll
            for (int g4 = 0; g4 < 4; ++g4) { u32x2 w; w.x = cvtpk_s(bu[cb][4 * g4], bu[cb][4 * g4 + 1]); w.y = cvtpk_s(bu[cb][4 * g4 + 2], bu[cb][4 * g4 + 3]);
                *(LAS u32x2*)(img + cb * IMGB + c32 * ROWB + 8 * (2 * g4 + hi)) = w; }
        asm volatile("s_waitcnt lgkmcnt(0)" ::: "memory");
        f32x16 yt = zero;
        { const int i16 = lane & 15, q = i16 >> 2, pp = i16 & 3, blk = (lane >> 4) & 1;
#pragma unroll
          for (int s = 0; s < 8; ++s) { const LAS unsigned char* tp = img + (s >> 1) * IMGB + (16 * (s & 1) + 8 * hi + q) * ROWB + 8 * (4 * blk + pp);
              const s16x4 lo = __builtin_bit_cast(s16x4, __builtin_amdgcn_ds_read_tr16_b64_v4i16((LAS v4i16_t*)tp));
              const s16x4 hh = __builtin_bit_cast(s16x4, __builtin_amdgcn_ds_read_tr16_b64_v4i16((LAS v4i16_t*)(tp + 4 * ROWB)));
              const bf16x8 xa = {lo[0], lo[1], lo[2], lo[3], hh[0], hh[1], hh[2], hh[3]};
              yt = MFMA32(ccfrag[s], xa, yt); } }
        asm volatile("s_waitcnt lgkmcnt(0)" ::: "memory");
        const int tok = 16 * sb + tr; const bool live = MODE == 2 ? tr < DS : true;
        const size_t mrow = (size_t)(rbA + (MODE == 2 ? trA : tok));
        float z[8];
        z[0] = gelu_tanh_f(yt[0] + dsk[0][0] * bf_lo(u0.x)); z[1] = gelu_tanh_f(yt[1] + dsk[0][1] * bf_hi(u0.x)); z[2] = gelu_tanh_f(yt[2] + dsk[0][2] * bf_lo(u0.y)); z[3] = gelu_tanh_f(yt[3] + dsk[0][3] * bf_hi(u0.y));
        z[4] = gelu_tanh_f(yt[4] + dsk[1][0] * bf_lo(u1.x)); z[5] = gelu_tanh_f(yt[5] + dsk[1][1] * bf_hi(u1.x)); z[6] = gelu_tanh_f(yt[6] + dsk[1][2] * bf_lo(u1.y)); z[7] = gelu_tanh_f(yt[7] + dsk[1][3] * bf_hi(u1.y));
        u32x4 zp; zp.x = cvtpk_s(z[0], z[1]); zp.y = cvtpk_s(z[2], z[3]); zp.z = cvtpk_s(z[4], z[5]); zp.w = cvtpk_s(z[6], z[7]);
        const f32x16 zz = MFMA32(wgfrag, __builtin_bit_cast(bf16x8, zp), zero);
        float o[8];
#pragma unroll
        for (int i = 0; i < 8; ++i) { const float gate = zz[i + 8] + bgg[i >> 2][i & 3]; o[i] = (zz[i] + bgv[i >> 2][i & 3]) / (1.f + __expf(-gate)); }
        if (live) { unsigned short* ob = (unsigned short*)(p.ws + WS_ASB) + mrow * D + AW + g * SG;
            u32x2 w0, w1; w0.x = cvtpk_s(o[0], o[1]); w0.y = cvtpk_s(o[2], o[3]); w1.x = cvtpk_s(o[4], o[5]); w1.y = cvtpk_s(o[6], o[7]);
            *(u32x2*)(ob + 4 * hi) = w0; *(u32x2*)(ob + 8 + 4 * hi) = w1; }
    }
    if (MODE == 0) { float* S = (float*)(p.ws + WS_SEND) + ((size_t)(hi * NG + g) * NCH + cidx) * 128 + c32;
#pragma unroll
        for (int pb = 0; pb < 2; ++pb) { S[32 * pb] = hr[pb]; S[64 + 32 * pb] = hm[pb]; } }
    if (MODE == 1 && cidx == NCH - 1) {
#pragma unroll
        for (int pb = 0; pb < 2; ++pb) { p.out[O_SRP + (size_t)(hi * NG + g) * SP + c32 + 32 * pb] = hr[pb]; p.out[O_SIP + (size_t)(hi * NG + g) * SP + c32 + 32 * pb] = hm[pb]; } }
    if (MODE == 2) {
#pragma unroll
        for (int pb = 0; pb < 2; ++pb) { p.out[O_SRS + (size_t)((cidx + 4 * hi) * NG + g) * SP + c32 + 32 * pb] = fr[pb]; p.out[O_SIS + (size_t)((cidx + 4 * hi) * NG + g) * SP + c32 + 32 * pb] = fm[pb]; } }
}
#undef MFMA32
}

__device__ __forceinline__ float block_incl_scan(float tot, LAS float* sh, int tid, int lane, int wave, float& all) {
    float v = tot;
#pragma unroll
    for (int o = 1; o < 64; o <<= 1) { const float n = __shfl_up(v, o); if (lane >= o) v += n; }
    __syncthreads();
    if (lane == 63) sh[wave] = v;
    __syncthreads();
    float off = 0.f, a = 0.f;
#pragma unroll
    for (int w = 0; w < NWAVES; ++w) { const float t = sh[w]; if (w < wave) off += t; a += t; }
    all = a; return v + off;
}
__device__ __forceinline__ void scan_fc(const P& p, Frame& F, int bh) {
    const int b = bh / NH, h = bh % NH; const float* lf = (const float*)(p.ws + WS_LF); float* fc = (float*)(p.ws + WS_FC) + (size_t)bh * SEQ;
    float v[8]; float s = 0.f;
#pragma unroll
    for (int i = 0; i < 8; ++i) { s += lf[(size_t)(b * SEQ + F.tid * 8 + i) * NH + h]; v[i] = s; }
    float all; const float incl = block_incl_scan(s, (LAS float*)F.lds, F.tid, F.lane, F.wave, all); const float off = incl - s;
#pragma unroll
    for (int i = 0; i < 8; ++i) fc[F.tid * 8 + i] = off + v[i];
    __syncthreads();
}
__device__ __forceinline__ void scan_dec(const P& p, Frame& F, int bh) {
    const int b = bh / NH, h = bh % NH; float* dec = (float*)(p.ws + WS_DEC) + (size_t)bh * PAST;
    const int pos0 = F.tid * 32; const int pg = p.pt[b * NPG + pos0 / PAGE];
    const float* src = p.clf + ((size_t)pg * PAGE + (pos0 % PAGE)) * NH + h;
    float v[32]; float s = 0.f;
#pragma unroll
    for (int i = 31; i >= 0; --i) { v[i] = s; s += src[(size_t)i * NH]; }
    float all; const float incl = block_incl_scan(s, (LAS float*)F.lds, F.tid, F.lane, F.wave, all); const float off = all - incl;
#pragma unroll
    for (int i = 0; i < 32; ++i) dec[pos0 + i] = off + v[i];
    __syncthreads();
}

__device__ __forceinline__ void p0_transpose_item(const float* W, int ldw, int K, int ncols, bf16* WT, int row_off, int item, int lane) {
    const int nblk = ncols / 64, kb = item / nblk, nb = item % nblk, k0 = 64 * kb, n0 = 64 * nb, cq = lane & 15, rg = lane >> 4;
    const float* src = W + (size_t)(k0 + 8 * rg) * ldw + n0 + 4 * cq;
    f32x4 f[2][8];
#pragma unroll
    for (int h = 0; h < 2; ++h)
#pragma unroll
        for (int i = 0; i < 8; ++i) f[h][i] = __builtin_nontemporal_load((const f32x4*)(src + (size_t)(32 * h + i) * ldw));
    bf16* dst = WT + (size_t)(row_off + n0 + 4 * cq) * K + k0 + 8 * rg;
#pragma unroll
    for (int h = 0; h < 2; ++h)
#pragma unroll
        for (int e = 0; e < 4; ++e) { v4u o; o.x = pk2(f[h][0][e], f[h][1][e]); o.y = pk2(f[h][2][e], f[h][3][e]); o.z = pk2(f[h][4][e], f[h][5][e]); o.w = pk2(f[h][6][e], f[h][7][e]);
            *(GAS v4u*)(dst + (size_t)e * K + 32 * h) = o; }
}
__device__ __forceinline__ void p0_mod(const P& p, Frame& F) {
    LAS float* S = (LAS float*)F.lds;
    const int kc = F.bid / 24, nc = F.bid % 24;
    for (int idx = F.tid; idx < NBT * 256; idx += NWAVES * 64) { const int r = idx >> 8, k = idx & 255; const float c = r < NB ? p.cp[r * D + 256 * kc + k] : p.cs[(r - NB) * D + 256 * kc + k];
        S[k * 12 + r] = c / (1.f + expf(-c)); }
    __syncthreads();
    const int n0 = 512 * nc + 64 * F.wave, cg = F.lane & 15, rq = F.lane >> 4;
    f32x4 acc[NBT];
#pragma unroll
    for (int r = 0; r < NBT; ++r) acc[r] = (f32x4){0.f, 0.f, 0.f, 0.f};
    const float* wp = p.w_ada + (size_t)(256 * kc + rq) * (NMOD * D) + n0 + 4 * cg;
#pragma unroll 8
    for (int it = 0; it < 64; ++it) {
        const f32x4 wv = __builtin_nontemporal_load((const f32x4*)(wp + (size_t)(4 * it) * (NMOD * D)));
        const LAS float* sk = S + (4 * it + rq) * 12;
        const f32x4 s0 = *(const LAS f32x4*)sk, s1 = *(const LAS f32x4*)(sk + 4); const f32x2 s2 = *(const LAS f32x2*)(sk + 8);
        acc[0] += wv * s0[0]; acc[1] += wv * s0[1]; acc[2] += wv * s0[2]; acc[3] += wv * s0[3];
        acc[4] += wv * s1[0]; acc[5] += wv * s1[1]; acc[6] += wv * s1[2]; acc[7] += wv * s1[3];
        acc[8] += wv * s2[0]; acc[9] += wv * s2[1];
    }
#pragma unroll
    for (int r = 0; r < NBT; ++r)
#pragma unroll
        for (int e = 0; e < 4; ++e) acc[r][e] = rows_sum(acc[r][e]);
    if (rq == 0) { float* part = (float*)(p.ws + WS_PART) + (size_t)kc * NBT * NMOD * D + n0 + 4 * cg;
#pragma unroll
        for (int r = 0; r < NBT; ++r) *(f32x4*)(part + (size_t)r * NMOD * D) = acc[r]; }
    VM_WAIT(); __syncthreads();
    if (F.tid == 0) { __builtin_amdgcn_fence(__ATOMIC_RELEASE, "agent"); VM_WAIT(); (void)xb_add((unsigned*)p.ws + CW_MOD, 1u); }
}
__device__ __forceinline__ float mod_reduce(const P& p, int idx  ) {
    const float* part = (const float*)(p.ws + WS_PART) + idx; float v = p.b_ada[idx % (NMOD * D)];
#pragma unroll
    for (int kc = 0; kc < 8; ++kc) v += part[(size_t)kc * NBT * NMOD * D];
    return v;
}
__device__ __forceinline__ void p0_prologue(const P& p, Frame& F) {
    constexpr int NMODWG = NMOD * D / 64;
    if (F.bid < NMODWG) p0_mod(p, F);
    else if (F.G == 256) { scan_dec(p, F, F.bid - NMODWG);
        if (F.bid < NMODWG + 8) ssm::build_tables(p, (F.bid - NMODWG) * NWAVES + F.wave, F.lane); }
    bf16* W1T = (bf16*)(p.ws + WS_W1T); bf16* W2T = (bf16*)(p.ws + WS_W2T); bf16* W3T = (bf16*)(p.ws + WS_W3T); bf16* W4T = (bf16*)(p.ws + WS_W4T);
    constexpr int I_1A = (D / 64) * (3 * AW / 64), I_1B = (D / 64) * (SW / 64), I_2 = (D / 64) * (D / 64), I_3 = (D / 64) * (DFF / 64), I_4 = (DFF / 64) * (D / 64);
    constexpr int NITEMS = I_1A + I_1B + I_2 + I_3 + I_4;
    constexpr int TS = NMODWG * NWAVES * 2 + (256 - NMODWG) * NWAVES * 3;
    int slot0, nsl;
    int sstep = 1;
    if (F.G == 256) { sstep = NWAVES; if (F.bid < NMODWG) { slot0 = F.bid * NWAVES * 2 + F.wave; nsl = 2; } else { slot0 = NMODWG * NWAVES * 2 + (F.bid - NMODWG) * NWAVES * 3 + F.wave; nsl = 3; } }
    else { slot0 = F.bid * NWAVES + F.wave; nsl = 1; }
    const int stride = F.G == 256 ? TS : F.G * NWAVES;
    for (int sl = 0; sl < nsl; ++sl)
        for (int it = slot0 + sl * sstep; it < NITEMS; it += stride) {
            int r = it;
            if (r < I_1A) { p0_transpose_item(p.w_in, INC, D, 3 * AW, W1T, 0, r, F.lane); continue; } r -= I_1A;
            if (r < I_1B) { p0_transpose_item(p.w_in + 3 * AW + NH, INC, D, SW, W1T, 3 * AW, r, F.lane); continue; } r -= I_1B;
            if (r < I_2) { p0_transpose_item(p.w_o, D, D, D, W2T, 0, r, F.lane); continue; } r -= I_2;
            if (r < I_3) { p0_transpose_item(p.w_up, DFF, D, DFF, W3T, 0, r, F.lane); continue; } r -= I_3;
            p0_transpose_item(p.w_down, D, DFF, D, W4T, 0, r, F.lane);
        }
}
__device__ __forceinline__ void row_stats(const f32x4 (&v)[8], float& mean, float& rstd) {
    float s = 0.f;
#pragma unroll
    for (int j = 0; j < 8; ++j) s += (v[j][0] + v[j][1]) + (v[j][2] + v[j][3]);
    mean = wave_sum(s) * (1.f / D); float q = 0.f;
#pragma unroll
    for (int j = 0; j < 8; ++j) { const f32x4 d = v[j] - mean; q += (d[0] * d[0] + d[1] * d[1]) + (d[2] * d[2] + d[3] * d[3]); }
    rstd = 1.f / sqrtf(wave_sum(q) * (1.f / D) + LN_EPS);
}
__device__ __forceinline__ void phase_l0(const P& p, Frame& F, unsigned* tmo_bar) {
    LAS float* WF = (LAS float*)F.lds;
    LAS float* ML = (LAS float*)(F.lds + 65536);
#pragma unroll 8
    for (int idx = F.tid; idx < D * NH; idx += NWAVES * 64) { const int c = idx >> 3, hh = idx & 7;
        WF[((((c >> 8) * 4 + (c & 3)) * 2 + (hh >> 2)) * 64 + ((c & 255) >> 2)) * 4 + (hh & 3)] = p.w_in[(size_t)c * INC + 3 * AW + hh]; }
    if (F.tid == 0) { XB_SPIN(xb_ld((unsigned*)p.ws + CW_MOD) < (unsigned)(NMOD * D / 64), tmo_bar); __builtin_amdgcn_fence(__ATOMIC_ACQUIRE, "agent"); VM_WAIT(); }
    __syncthreads();
    { float* mod = (float*)(p.ws + WS_MOD);
      if (F.G == 256) { if (F.tid < 480) { const int idx = F.bid * 480 + F.tid; mod[idx] = mod_reduce(p, idx); } }
      else for (int idx = F.bid * NWAVES * 64 + F.tid; idx < NBT * NMOD * D; idx += F.G * NWAVES * 64) mod[idx] = mod_reduce(p, idx);
      const int nsel = (F.bid < DB) ? 3 : 2;
      for (int i0 = 0; i0 < nsel * 2 * D; i0 += 8 * NWAVES * 64) { float v[8];
#pragma unroll
          for (int k = 0; k < 8; ++k) { const int idx = i0 + k * NWAVES * 64 + F.tid, bsel = idx / (2 * D), rem = idx % (2 * D), b = bsel < 2 ? bsel : NB + F.bid; v[k] = mod_reduce(p, b * NMOD * D + rem); }
#pragma unroll
          for (int k = 0; k < 8; ++k) { const int idx = i0 + k * NWAVES * 64 + F.tid, rem = idx % (2 * D); ML[idx] = rem < D ? v[k] : 1.0f + v[k]; } } }
    __syncthreads();
    bf16* Hb = (bf16*)(p.ws + WS_HB); float* LF = (float*)(p.ws + WS_LF);
    const int gw = F.bid * NWAVES + F.wave, NGW = F.G * NWAVES;
    f32x4 nv[8];
    if (gw < M) { const GAS f32x4* xr = (const GAS f32x4*)xrow(p, gw) + F.lane;
#pragma unroll
        for (int j = 0; j < 8; ++j) nv[j] = xr[64 * j]; }
    for (int m = gw; m < M; m += NGW) {
        f32x4 v[8];
#pragma unroll
        for (int j = 0; j < 8; ++j) v[j] = nv[j];
        if (m + NGW < M) { const GAS f32x4* xr = (const GAS f32x4*)xrow(p, m + NGW) + F.lane;
#pragma unroll
            for (int j = 0; j < 8; ++j) nv[j] = xr[64 * j]; }
        float mean, rstd; row_stats(v, mean, rstd);
        const int bsel = m < MP ? m / SEQ : 2;
        const LAS f32x4* sh1 = (const LAS f32x4*)(ML + bsel * 2 * D) + F.lane; const LAS f32x4* sc1 = (const LAS f32x4*)(ML + bsel * 2 * D + D) + F.lane;
        GAS v2u* o8 = (GAS v2u*)(Hb + (size_t)m * D) + F.lane;
        f32x2 fp[4];
#pragma unroll
        for (int e = 0; e < 4; ++e) fp[e] = (f32x2){0.f, 0.f};
#pragma unroll
        for (int j = 0; j < 8; ++j) {
            const f32x4 h = (v[j] - mean) * rstd * sc1[64 * j] + sh1[64 * j];
            v2u o; o.x = pk2(h[0], h[1]); o.y = pk2(h[2], h[3]); o8[64 * j] = o;
            const LAS f32x4* wf = (const LAS f32x4*)WF + j * 512 + F.lane;
#pragma unroll
            for (int e = 0; e < 4; ++e) { const f32x4 w0 = wf[(2 * e) * 64], w1 = wf[(2 * e + 1) * 64]; const f32x2 hh = {h[e], h[e]};
                fp[0] += hh * (f32x2){w0[0], w0[1]}; fp[1] += hh * (f32x2){w0[2], w0[3]}; fp[2] += hh * (f32x2){w1[0], w1[1]}; fp[3] += hh * (f32x2){w1[2], w1[3]}; }
            asm volatile("" ::: "memory");
        }
        float fl[8];
#pragma unroll
        for (int e = 0; e < 8; ++e) fl[e] = wave_sum(fp[e >> 1][e & 1]);
        if (F.lane < 8) {
            float f = fl[0];
#pragma unroll
            for (int e = 1; e < 8; ++e) f = (F.lane == e) ? fl[e] : f;
            const float lf = log_sigmoid(f + p.b_f[F.lane]);
            LF[(size_t)m * NH + F.lane] = lf;
            if (m < MP) p.out[O_LFP + (size_t)m * NH + F.lane] = lf; else p.out[O_LFS + (size_t)(m - MP) * NH + F.lane] = lf;
        }
    }
    __syncthreads();
}
__device__ __forceinline__ f32x4 unpk4(v2u w) { return (f32x4){__builtin_bit_cast(float, w.x << 16), __builtin_bit_cast(float, w.x & 0xffff0000u), __builtin_bit_cast(float, w.y << 16), __builtin_bit_cast(float, w.y & 0xffff0000u)}; }
__device__ __forceinline__ void phase_l1(const P& p, Frame& F) {
    bf16* Hb = (bf16*)(p.ws + WS_HB); const bf16* T = (const bf16*)(p.ws + WS_T); bf16* X1 = (bf16*)(p.ws + WS_X1);
    const int gw = F.bid * NWAVES + F.wave, NGW = F.G * NWAVES;
    f32x4 g1[8], b1[8];
#pragma unroll
    for (int j = 0; j < 8; ++j) { g1[j] = ((const GAS f32x4*)p.ln1_g + F.lane)[64 * j]; b1[j] = ((const GAS f32x4*)p.ln1_b + F.lane)[64 * j]; }
    v2u nv[8];
    if (gw < M) { const GAS v2u* tr = (const GAS v2u*)(T + (size_t)gw * D) + F.lane;
#pragma unroll
        for (int j = 0; j < 8; ++j) nv[j] = tr[64 * j]; }
    for (int m = gw; m < M; m += NGW) {
        f32x4 v[8];
#pragma unroll
        for (int j = 0; j < 8; ++j) v[j] = unpk4(nv[j]);
        if (m + NGW < M) { const GAS v2u* tr = (const GAS v2u*)(T + (size_t)(m + NGW) * D) + F.lane;
#pragma unroll
            for (int j = 0; j < 8; ++j) nv[j] = tr[64 * j]; }
        const int b = brow(m);
        const GAS f32x4* sh2 = (const GAS f32x4*)modp(p, b, 3) + F.lane; const GAS f32x4* sc2 = (const GAS f32x4*)modp(p, b, 4) + F.lane;
        f32x4 s2[8], h2[8];
#pragma unroll
        for (int j = 0; j < 8; ++j) { s2[j] = sc2[64 * j]; h2[j] = sh2[64 * j]; }
        float mean, rstd; row_stats(v, mean, rstd);
        GAS v2u* xo = (GAS v2u*)(X1 + (size_t)m * D) + F.lane;
#pragma unroll
        for (int j = 0; j < 8; ++j) { v[j] = (v[j] - mean) * rstd * g1[j] + b1[j]; v2u o; o.x = pk2(v[j][0], v[j][1]); o.y = pk2(v[j][2], v[j][3]); xo[64 * j] = o; }
        row_stats(v, mean, rstd);
        GAS v2u* o8 = (GAS v2u*)(Hb + (size_t)m * D) + F.lane;
#pragma unroll
        for (int j = 0; j < 8; ++j) { const f32x4 h = (v[j] - mean) * rstd * (s2[j] + 1.0f) + h2[j];
            v2u o; o.x = pk2(h[0], h[1]); o.y = pk2(h[2], h[3]); o8[64 * j] = o; }
    }
}
__device__ __forceinline__ void phase_l2(const P& p, Frame& F) {
    const bf16* T = (const bf16*)(p.ws + WS_T);
    const int gw = F.bid * NWAVES + F.wave, NGW = F.G * NWAVES;
    f32x4 g2[8], b2[8];
#pragma unroll
    for (int j = 0; j < 8; ++j) { g2[j] = ((const GAS f32x4*)p.ln2_g + F.lane)[64 * j]; b2[j] = ((const GAS f32x4*)p.ln2_b + F.lane)[64 * j]; }
    v2u nv[8];
    if (gw < M) { const GAS v2u* tr = (const GAS v2u*)(T + (size_t)gw * D) + F.lane;
#pragma unroll
        for (int j = 0; j < 8; ++j) nv[j] = tr[64 * j]; }
    for (int m = gw; m < M; m += NGW) {
        f32x4 v[8];
#pragma unroll
        for (int j = 0; j < 8; ++j) v[j] = unpk4(nv[j]);
        if (m + NGW < M) { const GAS v2u* tr = (const GAS v2u*)(T + (size_t)(m + NGW) * D) + F.lane;
#pragma unroll
            for (int j = 0; j < 8; ++j) nv[j] = tr[64 * j]; }
        float mean, rstd; row_stats(v, mean, rstd);
        GAS f32x4* yo = (GAS f32x4*)(m < MP ? p.out + O_YP + (size_t)m * D : p.out + O_YS + (size_t)(m - MP) * D) + F.lane;
#pragma unroll
        for (int j = 0; j < 8; ++j) yo[64 * j] = (v[j] - mean) * rstd * g2[j] + b2[j];
    }
}
template <int NST, class Epi>
__device__ __forceinline__ void skinny_gemm(Frame& F, const bf16* A, const bf16* Bt, int N, int K, unsigned* cnt, unsigned char* ws, size_t part_off, const Epi& E) {
    constexpr int KC = 512, PITCH = KC * 2 + 16, WPS = NWAVES / NST, KSW = 16 / WPS, NC = 16 * NST;
    LAS unsigned char* As = F.lds;
    LAS float* red = (LAS float*)(F.lds + 67584);
    LAS unsigned* flag = (LAS unsigned*)(F.lds + 67584 + 32768);
    const int nks = K / KC, nns = N / NC, r16 = F.lane & 15, kq = F.lane >> 4;
    const __amdgpu_buffer_rsrc_t rw = __builtin_amdgcn_make_buffer_rsrc((void*)ws, (short)0, 0x7fffffff, 0x00020000);
    for (int u = F.bid; u < nks * nns; u += F.G) {
        const int ns = u % nns, ks = u / nns;
        { const int row = F.wave * 8 + (F.lane >> 3), seg = F.lane & 7; const bf16* src = A + (size_t)row * K + ks * KC + seg * 8; v4u t[8];
#pragma unroll
          for (int i = 0; i < 8; ++i) t[i] = *(const GAS v4u*)(src + i * 64);
#pragma unroll
          for (int i = 0; i < 8; ++i) *(LAS v4u*)(As + row * PITCH + (i * 8 + seg) * 16) = t[i]; }
        const int strip = F.wave % NST, kpart = F.wave / NST;
        const bf16* bp = Bt + (size_t)(ns * NC + strip * 16 + r16) * K + ks * KC + kpart * KSW * 32 + 8 * kq;
        bf16x8 bq[KSW];
#pragma unroll
        for (int j = 0; j < KSW; ++j) bq[j] = *(const bf16x8*)(bp + 32 * j);
        __syncthreads();
        f32x4 acc[4];
#pragma unroll
        for (int rb = 0; rb < 4; ++rb) acc[rb] = (f32x4){0.f, 0.f, 0.f, 0.f};
#pragma unroll
        for (int j = 0; j < KSW; ++j)
#pragma unroll
            for (int rb = 0; rb < 4; ++rb) { const bf16x8 a = *(const LAS bf16x8*)(As + (rb * 16 + r16) * PITCH + ((kpart * KSW + j) * 32 + 8 * kq) * 2);
                acc[rb] = __builtin_amdgcn_mfma_f32_16x16x32_bf16(a, bq[j], acc[rb], 0, 0, 0); }
#pragma unroll
        for (int rb = 0; rb < 4; ++rb)
#pragma unroll
            for (int i = 0; i < 4; ++i) red[(F.wave * 64 + rb * 16 + 4 * kq + i) * 16 + r16] = acc[rb][i];
        __syncthreads();
        for (int e = F.tid; e < 64 * NC / 4; e += NWAVES * 64) { const int row = e / (NC / 4), c4 = (e % (NC / 4)) * 4, st = c4 >> 4; f32x4 v = {0.f, 0.f, 0.f, 0.f};
#pragma unroll
            for (int w = 0; w < WPS; ++w) v += *(const LAS f32x4*)(red + ((w * NST + st) * 64 + row) * 16 + (c4 & 15));
            __builtin_amdgcn_raw_buffer_store_b128(__builtin_bit_cast(v4u, v), rw, (int)(part_off + (((size_t)ks * 64 + row) * N + ns * NC + c4) * 4), 0, 16  ); }
        VM_WAIT(); __syncthreads();
        if (F.tid == 0) { const unsigned old = xb_add(cnt + 16 * ns, 1u); const unsigned last = (old == (unsigned)(nks - 1)) ? 1u : 0u;
            if (last) { __builtin_amdgcn_fence(__ATOMIC_ACQUIRE, "agent"); VM_WAIT(); } flag[0] = last; }
        __syncthreads();
        if (flag[0]) {
            const float* p0 = (const float*)(ws + part_off) + ns * NC;
            for (int e = F.tid; e < 64 * NC / 4; e += NWAVES * 64) { const int row = e / (NC / 4), c4 = (e % (NC / 4)) * 4; f32x4 v = {0.f, 0.f, 0.f, 0.f};
                for (int k2 = 0; k2 < nks; ++k2) v += *(const f32x4*)(p0 + ((size_t)k2 * 64 + row) * N + c4);
#pragma unroll
                for (int i = 0; i < 4; ++i) E(row, ns * NC + c4 + i, v[i]); } }
        __syncthreads();
    }
}
struct SEpi1 { const P* p;
    __device__ __forceinline__ void operator()(int row, int n, float v) const { const P& q = *p; const int region = n >> 10, c = n & 1023; const size_t o = (size_t)(MP + row) * 1024 + c; const bf16 h = (bf16)f2bf(v);
        if (region == 0) { ((bf16*)(q.ws + WS_QB))[o] = h; }
        else if (region == 1) { ((bf16*)(q.ws + WS_KB))[o] = h; q.out[O_KS + (size_t)row * 1024 + c] = v; }
        else if (region == 2) { ((bf16*)(q.ws + WS_VB))[o] = h; q.out[O_VS + (size_t)row * 1024 + c] = v; }
        else { ((bf16*)(q.ws + WS_UB))[o] = h; } } };
template <bool BASE_F32> struct SEpiRes { const P* p; const void* base; int gi;
    __device__ __forceinline__ void operator()(int row, int n, float v) const { const P& q = *p;
        const float bs = BASE_F32 ? ((const float*)base)[(size_t)row * D + n] : __builtin_bit_cast(float, (unsigned)((const bf16*)base)[(size_t)row * D + n] << 16);
        ((bf16*)(q.ws + WS_T))[(size_t)(MP + row) * D + n] = (bf16)f2bf(ALPHA * bs + (1.f + modp(q, NB + row / DS, gi)[n]) * v); } };
struct SEpiRelu2 { const P* p;
    __device__ __forceinline__ void operator()(int row, int n, float v) const { const float r = fmaxf(v, 0.f); ((bf16*)(p->ws + WS_AB))[(size_t)(MP + row) * DFF + n] = (bf16)f2bf(r * r); } };

namespace att {
constexpr int D = 128, RS = 1024  , OS = 2048  ; constexpr float THR = 8.f; constexpr bool WSKIP = false;
constexpr float SCALE = 0.08838834764831845f, RSCALE = 11.313708498984761f;
constexpr int NW = 8, QBLK = 32, KVBLK = 64, QB = NW * QBLK;
constexpr int SHM_V = KVBLK * D * 2, SHM_K = KVBLK * D * 2;
constexpr int LDS_FJ = 2 * SHM_V + 2 * SHM_K + NW * 64 * 4;
constexpr int LDS_BYTES = LDS_FJ + 2 * 256;

using bf16 = unsigned short;
typedef short bf16x8 __attribute__((ext_vector_type(8)));
typedef short s16x4 __attribute__((ext_vector_type(4)));
typedef float f32x16 __attribute__((ext_vector_type(16)));
typedef float f32x4 __attribute__((ext_vector_type(4)));
typedef unsigned u32x4 __attribute__((ext_vector_type(4)));
template <class A, class Bt> struct same_t { static constexpr bool v = false; };
template <class A> struct same_t<A, A> { static constexpr bool v = true; };

#define KSWZ(row, colB) ((row) * 256 + ((colB) ^ (((row) & 7) << 4)))
#define SBAR() __builtin_amdgcn_sched_barrier(0)
__device__ __forceinline__ int v_st(int k, int c) { const int kk = (k & ~0xC) | ((k & 4) << 1) | ((k & 8) >> 1); return ((kk >> 3) * 4 + (c >> 5)) * 512 + ((kk & 7) * 32 + (c & 31)) * 2; }
__device__ __forceinline__ int v_rd_base(int lane) { return ((lane & 3) << 3) | (((lane >> 2) & 3) << 6) | (((lane >> 4) & 1) << 5) | (((lane >> 5) & 1) << 8); }
constexpr int v_rd_off(int d0, int ks, int half) { return d0 * 512 + ks * 4096 + half * 2048; }
__device__ __forceinline__ int crow(int r, int hi) { return (r & 3) + 8 * (r >> 2) + 4 * hi; }
__device__ __forceinline__ unsigned cvtpk(float lo, float hi) {
    unsigned r; asm volatile("v_cvt_pk_bf16_f32 %0, %1, %2" : "=v"(r) : "v"(lo), "v"(hi)); return r;
}
__device__ __forceinline__ bf16x8 pack8(f32x4 a, f32x4 b) {
    u32x4 w = {cvtpk(a[0], a[1]), cvtpk(a[2], a[3]), cvtpk(b[0], b[1]), cvtpk(b[2], b[3])};
    return *reinterpret_cast<bf16x8*>(&w);
}
template <class T> __device__ __forceinline__ bf16x8 load8(const T* p) {
    if constexpr (same_t<T, float>::v) { return pack8(*(const f32x4*)p, *(const f32x4*)(p + 4)); }
    else { return *reinterpret_cast<const bf16x8*>(p); }
}
__device__ __forceinline__ void mask_tile(f32x16& p0, f32x16& p1, int dq, unsigned W) {
    const float NEG = -__builtin_inff();
#pragma unroll
    for (int r = 0; r < 16; ++r) {
        const int c = (r & 3) + 8 * (r >> 2);
        if ((unsigned)(dq - c) >= W) p0[r] = NEG;
        if ((unsigned)(dq - c - 32) >= W) p1[r] = NEG;
    }
}
__device__ __forceinline__ void partialSM(f32x16& p0, f32x16& p1, float& m_reg, float& mn, float& alpha) {
    float pmax = p0[0]; for (int r = 1; r < 16; ++r) pmax = fmaxf(pmax, p0[r]); for (int r = 0; r < 16; ++r) pmax = fmaxf(pmax, p1[r]);
    { auto rr = __builtin_amdgcn_permlane32_swap(__float_as_uint(pmax), __float_as_uint(pmax), false, false);
      pmax = fmaxf(__uint_as_float(rr[0]), __uint_as_float(rr[1])); }
    constexpr float C2 = 1.4426950408889634f * SCALE;
    if (__builtin_expect(__all((pmax - m_reg) * SCALE <= THR), 1)) { mn = m_reg; alpha = 1.f; }
    else { mn = fmaxf(m_reg, pmax); alpha = __builtin_amdgcn_exp2f((m_reg - mn) * C2); m_reg = mn; }
    const float mnL = -mn * C2;
    for (int r = 0; r < 16; ++r) p0[r] = fmaf(p0[r], C2, mnL); for (int r = 0; r < 16; ++r) p1[r] = fmaf(p1[r], C2, mnL);
    for (int r = 0; r < 16; ++r) p0[r] = __builtin_amdgcn_exp2f(p0[r]);
}
__device__ __forceinline__ void finishSM(f32x16& p0, f32x16& p1, float alpha, float& l_reg, bf16x8& pa0, bf16x8& pa1, bf16x8& pa2, bf16x8& pa3) {
    for (int r = 0; r < 16; ++r) p1[r] = __builtin_amdgcn_exp2f(p1[r]);
    float ps = 0; for (int r = 0; r < 16; ++r) ps += p0[r]; for (int r = 0; r < 16; ++r) ps += p1[r];
    { auto rr = __builtin_amdgcn_permlane32_swap(__float_as_uint(ps), __float_as_uint(ps), false, false);
      ps = __uint_as_float(rr[0]) + __uint_as_float(rr[1]); }
    l_reg = l_reg * alpha + ps;
#define PK4(P, B_, OUT) do { unsigned a0 = cvtpk(P[B_+0], P[B_+1]), a1 = cvtpk(P[B_+2], P[B_+3]);                          \
        unsigned b0 = cvtpk(P[B_+4], P[B_+5]), b1 = cvtpk(P[B_+6], P[B_+7]);                                             \
        auto r0 = __builtin_amdgcn_permlane32_swap(a0, b0, false, false); auto r1 = __builtin_amdgcn_permlane32_swap(a1, b1, false, false); \
        u32x4 w = {r0[0], r1[0], r0[1], r1[1]}; OUT = *reinterpret_cast<bf16x8*>(&w); } while (0)
    PK4(p0, 0, pa0); PK4(p0, 8, pa1); PK4(p1, 0, pa2); PK4(p1, 8, pa3);
#undef PK4
}
template <int KB, bool SK>
__device__ __forceinline__ void qkt(f32x16& p0, f32x16& p1, const char* K_lds, int r32, int hi, const bf16x8* qr, bool act, float fi) {
    if (SK && !act) { const float NEG = -__builtin_inff();
#pragma unroll
        for (int r = 0; r < 16; ++r) { p0[r] = NEG; p1[r] = NEG; } return; }
    { const char* fjp = K_lds + 2 * SHM_K + NW * 64 * 4 + KB * 256 + hi * 16;
#pragma unroll
      for (int g = 0; g < 4; ++g) { const f32x4 a = *reinterpret_cast<const f32x4*>(fjp + 32 * g), b = *reinterpret_cast<const f32x4*>(fjp + 128 + 32 * g);
#pragma unroll
        for (int e = 0; e < 4; ++e) { p0[4 * g + e] = fi - a[e]; p1[4 * g + e] = fi - b[e]; } } }
    const char* kb[4];
#pragma unroll
    for (int dd = 0; dd < 4; ++dd) kb[dd] = K_lds + KB * SHM_K + KSWZ(r32, (dd * 16 + hi * 8) * 2);
#pragma unroll
    for (int d0 = 0; d0 < 8; ++d0) { const char* a = kb[d0 & 3] + (d0 >> 2) * 128;
        bf16x8 b0 = *reinterpret_cast<const bf16x8*>(a);
        bf16x8 b1 = *reinterpret_cast<const bf16x8*>(a + 32 * 256);
        p0 = __builtin_amdgcn_mfma_f32_32x32x16_bf16(b0, qr[d0], p0, 0, 0, 0);
        p1 = __builtin_amdgcn_mfma_f32_32x32x16_bf16(b1, qr[d0], p1, 0, 0, 0); }
}
template <int VB, bool SK>
__device__ __forceinline__ void pv_tile(f32x16* o, int vb0, bf16x8 pa0, bf16x8 pa1, bf16x8 pa2, bf16x8 pa3, bool act) {
    if (SK && !act) return;
#define TRRD(dst, off) asm volatile("ds_read_b64_tr_b16 %0, %1 offset:%2" : "=&v"(dst) : "v"(vb0), "i"(off) : "memory")
#define PV_D0(d0) do { s16x4 l0, l1, l2, l3, h0, h1, h2, h3; constexpr int b_ = VB * SHM_V + v_rd_off(d0, 0, 0);     \
        TRRD(l0, b_); TRRD(h0, b_ + 2048); TRRD(l1, b_ + 4096); TRRD(h1, b_ + 6144); TRRD(l2, b_ + 8192); TRRD(h2, b_ + 10240); TRRD(l3, b_ + 12288); TRRD(h3, b_ + 14336); \
        asm volatile("s_waitcnt lgkmcnt(0)" ::: "memory"); SBAR();                 \
        o[d0] = __builtin_amdgcn_mfma_f32_32x32x16_bf16(pa0, (bf16x8){l0[0], l0[1], l0[2], l0[3], h0[0], h0[1], h0[2], h0[3]}, o[d0], 0, 0, 0);   \
        o[d0] = __builtin_amdgcn_mfma_f32_32x32x16_bf16(pa1, (bf16x8){l1[0], l1[1], l1[2], l1[3], h1[0], h1[1], h1[2], h1[3]}, o[d0], 0, 0, 0);   \
        o[d0] = __builtin_amdgcn_mfma_f32_32x32x16_bf16(pa2, (bf16x8){l2[0], l2[1], l2[2], l2[3], h2[0], h2[1], h2[2], h2[3]}, o[d0], 0, 0, 0);   \
        o[d0] = __builtin_amdgcn_mfma_f32_32x32x16_bf16(pa3, (bf16x8){l3[0], l3[1], l3[2], l3[3], h3[0], h3[1], h3[2], h3[3]}, o[d0], 0, 0, 0); } while (0)
    PV_D0(0); PV_D0(1); PV_D0(2); PV_D0(3);
#undef PV_D0
#undef TRRD
}

template <class TIn, class TOut> struct BlockRef { unsigned Q, K, V, O, F; int P0; };
#define BL128(vo, so) __builtin_bit_cast(bf16x8, __builtin_amdgcn_raw_buffer_load_b128(rs, (int)(vo), (int)(so), 0))
#define BL32F(vo, so) __builtin_bit_cast(float, __builtin_amdgcn_raw_buffer_load_b32(rs, (int)(vo), (int)(so), 0))
template <class TIn> struct Seam {
    bf16x8 qr[8];
    bf16x8 st_v0, st_v1, st_k0, st_k1; float st_f;
};
__device__ __forceinline__ int swa_jlo(int P0, int W) { const int lowk = P0 - W + 1; return lowk > 0 ? lowk / KVBLK : 0; }
#define VMW() asm volatile("s_waitcnt vmcnt(0)" ::: "memory")
#define VMWN(n) asm volatile("s_waitcnt vmcnt(%0)" :: "i"(n) : "memory")
#define SLOAD_H(Kp, Vp, Fp, k0) do { const unsigned so_ = (unsigned)(k0) * (RS * 2); S.st_v0 = BL128(lkv, (Vp) + so_); S.st_v1 = BL128(lkv, (Vp) + so_ + 32 * RS * 2); \
                         S.st_k0 = BL128(lkv, (Kp) + so_); S.st_k1 = BL128(lkv, (Kp) + so_ + 32 * RS * 2); S.st_f = BL32F((tid & 63) * 4, (Fp) + (unsigned)(k0) * 4); } while (0)
#define SWRITE_HK(bf) do { *(bf16x8*)(K_lds + (bf) * SHM_K + kws) = S.st_k0; *(bf16x8*)(K_lds + (bf) * SHM_K + kws + 32 * 256) = S.st_k1; \
                           if (tid < 64) *(float*)(K_lds + 2 * SHM_K + NW * 64 * 4 + (bf) * 256 + tid * 4) = S.st_f * RSCALE; } while (0)
#define SWRITE_HV(bf) do { *(bf16x8*)(V_lds + (bf) * SHM_V + vst0) = S.st_v0; *(bf16x8*)(V_lds + (bf) * SHM_V + vst1) = S.st_v1; } while (0)
#define SWRITE_H(bf) do { SWRITE_HV(bf); SWRITE_HK(bf); } while (0)
template <class TIn, class TOut>
__device__ __forceinline__ void causal_swa_prime(const BlockRef<TIn, TOut>& cur, int W, char* lds, Seam<TIn>& S, __amdgpu_buffer_rsrc_t rs, const int tid_in) {
    constexpr bool F32 = same_t<TIn, float>::v;
    const int tid = tid_in, wid = __builtin_amdgcn_readfirstlane(tid >> 6), lane = tid & 63, r32 = lane & 31, hi = lane >> 5;
    const int sr = tid >> 4, sc = (tid & 15) * 8, kws = KSWZ(sr, sc * 2); char* K_lds = lds + 2 * SHM_V;
    const int lkv = (sr * RS + sc) * 2, lq = ((wid * QBLK + r32) * RS + hi * 8) * 2;
    const int kb0 = swa_jlo(cur.P0, W) * KVBLK;
#pragma unroll
    for (int d0 = 0; d0 < 8; ++d0) S.qr[d0] = BL128(lq + d0 * 32, cur.Q);
    SLOAD_H(cur.K, cur.V, cur.F, kb0); VMW(); SWRITE_HK(0);
    __syncthreads();
}
template <class TIn, class TOut>
__device__ __forceinline__ void causal_swa_block(const BlockRef<TIn, TOut>& cur, const BlockRef<TIn, TOut>& nxt, int skv, int W, char* lds, Seam<TIn>& S, __amdgpu_buffer_rsrc_t rs, const int tid_in) {
    constexpr bool F32 = same_t<TIn, float>::v;
    const int tid = tid_in, wid = __builtin_amdgcn_readfirstlane(tid >> 6), lane = tid & 63, r32 = lane & 31, hi = lane >> 5;
    const int j_lo = swa_jlo(cur.P0, W);
    int j_hi = (cur.P0 + QB - 1) / KVBLK + 1; if (j_hi > skv / KVBLK) j_hi = skv / KVBLK;
    const int NT = j_hi - j_lo;
    const int kbn = swa_jlo(nxt.P0, W) * KVBLK;
    const int qlo = cur.P0 + wid * QBLK, qm = qlo + r32 - 4 * hi;
    char* V_lds = lds; char* K_lds = lds + 2 * SHM_V;
    float* ws = (float*)(lds + 2 * SHM_V + 2 * SHM_K) + wid * 64; float* li_l = ws, * al_l = ws + 32;
    float m_reg = -1e30f, l_reg = 0; f32x16 o[4] = {};
    const int sr = tid >> 4, sc = (tid & 15) * 8, vst0 = v_st(sr, sc), vst1 = v_st(32 + sr, sc), kws = KSWZ(sr, sc * 2);
    const int vb0 = (int)(uintptr_t)V_lds + v_rd_base(lane);
    const unsigned Kh = cur.K, Vh = cur.V, Fh = cur.F;
    const int lkv = (sr * RS + sc) * 2, lq = ((wid * QBLK + r32) * RS + hi * 8) * 2;
    const float fi = BL32F((wid * QBLK + r32) * 4, cur.F + (unsigned)cur.P0 * 4) * RSCALE;
#define RESC(a) do { if (__any((a) < 1.f)) { if (hi == 0) al_l[r32] = (a); asm volatile("s_waitcnt lgkmcnt(0)" ::: "memory");              \
                     for (int d_ = 0; d_ < 4; ++d_) for (int r = 0; r < 16; ++r) o[d_][r] *= al_l[crow(r, hi)]; } } while (0)
#define KBASE(t) ((j_lo + (t)) * KVBLK)
#define ACT(t) (KBASE(t) <= qlo + QBLK - 1 && KBASE(t) + KVBLK - 1 >= qlo - W + 1)
#define MASKT(P0_, P1_, t) do { const int kb_ = KBASE(t); if ((!SK || ACT(t)) && (kb_ + KVBLK - 1 > qlo || kb_ <= qlo + QBLK - 1 - W)) mask_tile(P0_, P1_, qm - kb_, (unsigned)W); } while (0)
    constexpr int NQL = F32 ? 16 : 8;
    constexpr bool SK = WSKIP && !F32;
#define SEAM_K0() do { VMWN(NQL); SWRITE_HK(0); SBAR(); } while (0)
    f32x16 pA0, pA1, pB0, pB1; float mnA, mnB, alA, alB; bf16x8 pa0, pa1, pa2, pa3;
    SWRITE_HV(0); SBAR();
    if (NT > 1) { SLOAD_H(Kh, Vh, Fh, KBASE(1)); }
    SBAR(); qkt<0, SK>(pA0, pA1, K_lds, r32, hi, S.qr, ACT(0), fi);
    MASKT(pA0, pA1, 0); partialSM(pA0, pA1, m_reg, mnA, alA);
    if (NT > 1) { VMW(); SWRITE_H(1); }
    __syncthreads();
#define HALF_STEP(PX0, PX1, mnX, alX, PY0, PY1, alY, t, KB, VB, SB) do {                                                      \
        SBAR(); qkt<KB, SK>(PX0, PX1, K_lds, r32, hi, S.qr, ACT(t), fi);                                         \
        finishSM(PY0, PY1, alY, l_reg, pa0, pa1, pa2, pa3); SBAR();                                                           \
        if ((t) + 1 < NT) { SLOAD_H(Kh, Vh, Fh, KBASE((t) + 1)); SBAR(); }                                                   \
        pv_tile<VB, SK>(o, vb0, pa0, pa1, pa2, pa3, ACT((t) - 1)); MASKT(PX0, PX1, (t)); partialSM(PX0, PX1, m_reg, mnX, alX);                                        \
        __syncthreads();                                                                                                      \
        if ((t) + 1 < NT) { VMW(); SWRITE_H(SB); }                                                                            \
        RESC(alX); __syncthreads(); } while (0)
    for (int t = 1; t + 1 < NT; t += 2) {
        HALF_STEP(pB0, pB1, mnB, alB, pA0, pA1, alA, t, 1, 0, 0);
        HALF_STEP(pA0, pA1, mnA, alA, pB0, pB1, alB, t + 1, 0, 1, 1);
    }
    const bool even = (NT & 1) == 0;
    if (even) { SBAR(); qkt<1, SK>(pB0, pB1, K_lds, r32, hi, S.qr, ACT(NT - 1), fi); SBAR(); }
    { SLOAD_H(nxt.K, nxt.V, nxt.F, kbn); SBAR();
#pragma unroll
        for (int d0 = 0; d0 < 8; ++d0) S.qr[d0] = BL128(lq + d0 * 32, nxt.Q); }
    SBAR();
    finishSM(pA0, pA1, alA, l_reg, pa0, pa1, pa2, pa3); SBAR();
    pv_tile<0, SK>(o, vb0, pa0, pa1, pa2, pa3, ACT(even ? NT - 2 : NT - 1));
    if (even) { MASKT(pB0, pB1, NT - 1); partialSM(pB0, pB1, m_reg, mnB, alB); __syncthreads(); RESC(alB);
        finishSM(pB0, pB1, alB, l_reg, pa0, pa1, pa2, pa3); SBAR(); pv_tile<1, SK>(o, vb0, pa0, pa1, pa2, pa3, ACT(NT - 1)); }
    SBAR(); SEAM_K0();
    if (hi == 0) li_l[r32] = l_reg; asm volatile("s_waitcnt lgkmcnt(0)" ::: "memory");
    float rli[16];
#pragma unroll
    for (int r = 0; r < 16; ++r) rli[r] = __builtin_amdgcn_rcpf(li_l[crow(r, hi)]);
    const int lo_ = ((wid * QBLK + 4 * hi) * OS + r32) * 2;
#pragma unroll
    for (int r = 0; r < 16; ++r) { const unsigned so_ = cur.O + (unsigned)(((r & 3) + 8 * (r >> 2)) * OS * 2);
#pragma unroll
        for (int d0 = 0; d0 < 4; ++d0) { const float v = o[d0][r] * rli[r];
            { const float vn = __builtin_bit_cast(float, __builtin_amdgcn_mov_dpp(__builtin_bit_cast(int, v), 0xB1, 0xf, 0xf, true));
                   if ((r32 & 1) == 0) __builtin_amdgcn_raw_buffer_store_b32(cvtpk(v, vn), rs, lo_ + d0 * 64, (int)so_, 0); } } }
    __syncthreads();
#undef RESC
#undef KBASE
#undef ACT
#undef MASKT
#undef SEAM_K0
#undef HALF_STEP
}
#undef ROW
#undef VMW
#undef VMWN
#undef SLOAD_H
#undef SWRITE_HK
#undef SWRITE_HV
#undef SWRITE_H

}


namespace dec {
using bf16x2 = __attribute__((ext_vector_type(2))) __bf16;
using u32x4  = __attribute__((ext_vector_type(4))) unsigned;
using f32x4  = __attribute__((ext_vector_type(4))) float;
using f32x8  = __attribute__((ext_vector_type(8))) float;
constexpr int GE = 8, GEP = 8, HPL = 2, SPL = (256 - 136) / DB, NGRP = PAST / 16;
constexpr float LOG2E = 1.4426950408889634f, C2 = SCALE * LOG2E;
typedef short s16x4_t __attribute__((ext_vector_type(4)));
typedef unsigned u32x2 __attribute__((ext_vector_type(2)));
__device__ __forceinline__ float dot2(unsigned k, unsigned q, float acc) { return __builtin_amdgcn_fdot2_f32_bf16(__builtin_bit_cast(bf16x2, k), __builtin_bit_cast(bf16x2, q), acc, false); }
__device__ __forceinline__ unsigned cvtpk(float lo, float hi) { unsigned r; asm volatile("v_cvt_pk_bf16_f32 %0, %1, %2" : "=v"(r) : "v"(lo), "v"(hi)); return r; }
template <int CTRL> __device__ __forceinline__ float dpp(float x) { return __builtin_bit_cast(float, __builtin_amdgcn_mov_dpp(__builtin_bit_cast(int, x), CTRL, 0xf, 0xf, true)); }
constexpr int XOR1 = 0xB1, XOR2 = 0x4E, XOR7 = 0x141, XOR8 = 0x128, ROR4 = 0x124;
__device__ __forceinline__ float xrow16_max(float x) {
  auto s = __builtin_amdgcn_permlane16_swap(__float_as_uint(x), __float_as_uint(x), false, false); x = fmaxf(__uint_as_float(s[0]), __uint_as_float(s[1]));
  auto t = __builtin_amdgcn_permlane32_swap(__float_as_uint(x), __float_as_uint(x), false, false); return fmaxf(__uint_as_float(t[0]), __uint_as_float(t[1])); }
__device__ __forceinline__ float xrow16_sum(float x) {
  auto s = __builtin_amdgcn_permlane16_swap(__float_as_uint(x), __float_as_uint(x), false, false); x = __uint_as_float(s[0]) + __uint_as_float(s[1]);
  auto t = __builtin_amdgcn_permlane32_swap(__float_as_uint(x), __float_as_uint(x), false, false); return __uint_as_float(t[0]) + __uint_as_float(t[1]); }
__device__ __forceinline__ u32x4 tobf2(u32x4 a, u32x4 b) { u32x4 w = {cvtpk(__uint_as_float(a[0]), __uint_as_float(a[1])), cvtpk(__uint_as_float(a[2]), __uint_as_float(a[3])), cvtpk(__uint_as_float(b[0]), __uint_as_float(b[1])), cvtpk(__uint_as_float(b[2]), __uint_as_float(b[3]))}; return w; }

__device__ __forceinline__ void split_wave(const P& p, int b, int s, int h, int lane, float* pex  , LAS unsigned char* slot  ) {
  const int r = lane >> 4, c = lane & 15;
  const unsigned short* Qb = (const unsigned short*)(p.ws + WS_QB);
  u32x4* qlds = reinterpret_cast<u32x4*>(pex + 256);
  if (r == 0) {
#pragma unroll
    for (int g = 0; g < GEP; ++g) { const unsigned short* qp = Qb + (size_t)(MP + b * DS + g) * AW + h * HD + 4 * c;
      const u32x2 q0 = *reinterpret_cast<const u32x2*>(qp), q1 = *reinterpret_cast<const u32x2*>(qp + 64); qlds[g * 16 + c] = (u32x4){q0.x, q0.y, q1.x, q1.y}; }
  }
  asm volatile("s_waitcnt vmcnt(0) lgkmcnt(0)" ::: "memory");
  const int gbeg = (s * NGRP) / SPL, gend = ((s + 1) * NGRP) / SPL, pg0 = gbeg >> 3;
  int btv = 0; if (lane < 16) { const int pgi = pg0 + lane; btv = p.pt[b * NPG + (pgi < NPG ? pgi : NPG - 1)]; }
  const __amdgpu_buffer_rsrc_t rk = __builtin_amdgcn_make_buffer_rsrc((void*)p.ck, (short)0, 0x7fffffff, 0x00020000), rv = __builtin_amdgcn_make_buffer_rsrc((void*)p.cv, (short)0, 0x7fffffff, 0x00020000);
  const __amdgpu_buffer_rsrc_t rw = __builtin_amdgcn_make_buffer_rsrc((void*)p.ws, (short)0, 0x7fffffff, 0x00020000);
  const int lo4 = (r * AW + h * HD + 4 * c) * 4;
  const int ld4 = (r + 4 * (c >> 2)) * 4; const int dbase = (int)WS_DEC + ((b * NH + h) * PAST) * 4;
#define GOFF(i_) const int phys_ = __builtin_amdgcn_readlane(btv, ((i_) >> 3) - pg0); const int so_ = phys_ * (PAGE * AW * 4) + ((i_) & 7) * (16 * AW * 4)
#define DISSUE(i_) do { GOFF(i_); \
    dn = __builtin_bit_cast(float, __builtin_amdgcn_raw_buffer_load_b32(rw, ld4, dbase + (i_) * 64, 0)); \
    _Pragma("unroll") for (int t_ = 0; t_ < 4; ++t_) { Kn[t_][0] = __builtin_amdgcn_raw_buffer_load_b128(rk, lo4, so_ + t_ * (4 * AW * 4), 2); Kn[t_][1] = __builtin_amdgcn_raw_buffer_load_b128(rk, lo4 + 256, so_ + t_ * (4 * AW * 4), 2); \
                                                      Vn[t_][0] = __builtin_amdgcn_raw_buffer_load_b128(rv, lo4, so_ + t_ * (4 * AW * 4), 2); Vn[t_][1] = __builtin_amdgcn_raw_buffer_load_b128(rv, lo4 + 256, so_ + t_ * (4 * AW * 4), 2); } } while (0)
#define DMAISSUE(i_) do { GOFF(i_); \
    dn2 = __builtin_bit_cast(float, __builtin_amdgcn_raw_buffer_load_b32(rw, ld4, dbase + (i_) * 64, 0)); \
    _Pragma("unroll") for (int t_ = 0; t_ < 4; ++t_) _Pragma("unroll") for (int hf_ = 0; hf_ < 2; ++hf_) { \
        __builtin_amdgcn_raw_ptr_buffer_load_lds(rk, (LAS void*)(slot + (t_ * 2 + hf_) * 1024), 16, lo4 + 256 * hf_, so_ + t_ * (4 * AW * 4), 0, 2); \
        __builtin_amdgcn_raw_ptr_buffer_load_lds(rv, (LAS void*)(slot + 8192 + (t_ * 2 + hf_) * 1024), 16, lo4 + 256 * hf_, so_ + t_ * (4 * AW * 4), 0, 2); } } while (0)
  u32x4 Kn[4][2], Vn[4][2]; float dn, dn2 = 0.f;
  float m[HPL], l[HPL]; f32x4 accm[8];
#pragma unroll
  for (int j = 0; j < HPL; ++j) { m[j] = -INFINITY; l[j] = 0.f; }
#pragma unroll
  for (int k = 0; k < 8; ++k) accm[k] = (f32x4){0.f, 0.f, 0.f, 0.f};
  auto math = [&](const u32x4 (&Kc)[4], const u32x2 (&Vb)[8], const float dcur) {
    float x[4 * GEP];
#pragma unroll
    for (int g = 0; g < GEP; ++g) { const u32x4 qg = qlds[g * 16 + c];
#pragma unroll
      for (int t = 0; t < 4; ++t) { float d = 0.f;
#pragma unroll
        for (int k = 0; k < 4; ++k) d = dot2(Kc[t][k], qg[k], d);
        x[t * GEP + g] = d; } }
#define TR_STEP(HALF, CTRL, BIT) _Pragma("unroll") for (int hh = 0; hh < (HALF); ++hh) _Pragma("unroll") for (int j = 0; j < HPL; ++j) { \
      const float lo_ = x[hh * HPL + j], hi_ = x[(hh + (HALF)) * HPL + j]; const float t1_ = lo_ + dpp<CTRL>(lo_), t2_ = hi_ + dpp<CTRL>(hi_); \
      x[hh * HPL + j] = (c & (BIT)) ? t2_ : t1_; }
    TR_STEP(8, XOR8, 8) TR_STEP(4, XOR7, 4) TR_STEP(2, XOR2, 2) TR_STEP(1, XOR1, 1)
#undef TR_STEP
    float pj[HPL], alpha[HPL];
#pragma unroll
    for (int j = 0; j < HPL; ++j) {
      const float sc = fmaf(x[j], C2, dcur);
      float pm = sc; pm = fmaxf(pm, dpp<ROR4>(pm)); pm = fmaxf(pm, dpp<XOR8>(pm)); pm = xrow16_max(pm);
      const float mn = fmaxf(m[j], pm), msub = (mn == -INFINITY) ? 0.f : mn;
      alpha[j] = __builtin_amdgcn_exp2f(m[j] - msub); pj[j] = __builtin_amdgcn_exp2f(sc - msub);
      l[j] = fmaf(l[j], alpha[j], pj[j]); m[j] = mn;
    }
#pragma unroll
    for (int j = 0; j < HPL; ++j) pex[(r * 8 + 2 * (c & 3) + j) * 4 + (c >> 2)] = pj[j];
    if (lane < 4) { pex[128 + 2 * lane] = alpha[0]; pex[128 + 2 * lane + 1] = alpha[1]; }
    asm volatile("s_waitcnt lgkmcnt(0)" ::: "memory");
    const f32x4 pa = *reinterpret_cast<const f32x4*>(pex + (r * 8 + (c & 7)) * 4);
    const f32x4 av = *reinterpret_cast<const f32x4*>(pex + 128 + 4 * (r & 1));
    asm volatile("s_waitcnt lgkmcnt(0)" ::: "memory");
    u32x2 pa16; pa16.x = cvtpk(pa[0], pa[1]); pa16.y = cvtpk(pa[2], pa[3]);
    if (c >= 8) { pa16.x = 0u; pa16.y = 0u; }
#pragma unroll
    for (int e = 0; e < 8; ++e) { accm[e] = accm[e] * av;
      accm[e] = __builtin_amdgcn_mfma_f32_16x16x16bf16_1k(__builtin_bit_cast(s16x4_t, pa16), __builtin_bit_cast(s16x4_t, Vb[e]), accm[e], 0, 0, 0); }
  };
  DISSUE(gbeg);
  if (gbeg + 1 < gend) DMAISSUE(gbeg + 1);
  for (int i = gbeg; i < gend; i += 2) {
    { u32x4 Kc[4]; u32x2 Vb[8];
#pragma unroll
      for (int t = 0; t < 4; ++t) Kc[t] = tobf2(Kn[t][0], Kn[t][1]);
#pragma unroll
      for (int e = 0; e < 8; ++e) { Vb[e].x = cvtpk(__uint_as_float(Vn[0][e >> 2][e & 3]), __uint_as_float(Vn[1][e >> 2][e & 3])); Vb[e].y = cvtpk(__uint_as_float(Vn[2][e >> 2][e & 3]), __uint_as_float(Vn[3][e >> 2][e & 3])); }
      const float dcur = dn * LOG2E;
      if (i + 2 < gend) DISSUE(i + 2);
      math(Kc, Vb, dcur); }
    if (i + 1 < gend) { u32x4 Kc[4]; u32x2 Vb[8];
      const float dcur = dn2 * LOG2E;
      if (i + 2 < gend) asm volatile("s_waitcnt vmcnt(17)" ::: "memory"); else asm volatile("s_waitcnt vmcnt(0)" ::: "memory");
      u32x4 Vr[4][2];
#pragma unroll
      for (int t = 0; t < 4; ++t) { const LAS u32x4* kp = (const LAS u32x4*)(slot + (t * 2) * 1024) + lane; const LAS u32x4* vp = (const LAS u32x4*)(slot + 8192 + (t * 2) * 1024) + lane;
        Kc[t] = tobf2(kp[0], kp[64]); Vr[t][0] = vp[0]; Vr[t][1] = vp[64]; }
#pragma unroll
      for (int e = 0; e < 8; ++e) { Vb[e].x = cvtpk(__uint_as_float(Vr[0][e >> 2][e & 3]), __uint_as_float(Vr[1][e >> 2][e & 3])); Vb[e].y = cvtpk(__uint_as_float(Vr[2][e >> 2][e & 3]), __uint_as_float(Vr[3][e >> 2][e & 3])); }
      asm volatile("s_waitcnt lgkmcnt(0)" ::: "memory");
      if (i + 3 < gend) DMAISSUE(i + 3);
      math(Kc, Vb, dcur); }
  }
#undef DISSUE
#undef DMAISSUE
#undef GOFF
#pragma unroll
  for (int j = 0; j < HPL; ++j) { float t = l[j]; t += dpp<ROR4>(t); t += dpp<XOR8>(t); l[j] = xrow16_sum(t); }
  float* po = (float*)(p.ws + WS_PO); float* pml = (float*)(p.ws + WS_PML);
  if (r < 2) {
#pragma unroll
    for (int i = 0; i < 4; ++i) { const size_t slot_ = (size_t)(((b * NH + h) * DS + 4 * r + i) * SPL + s);
      *reinterpret_cast<f32x4*>(po + slot_ * HD + 4 * c) = f32x4{accm[0][i], accm[1][i], accm[2][i], accm[3][i]};
      *reinterpret_cast<f32x4*>(po + slot_ * HD + 64 + 4 * c) = f32x4{accm[4][i], accm[5][i], accm[6][i], accm[7][i]}; } }
  if (r == 0) {
#pragma unroll
    for (int g = 0; g < GE; ++g) { const size_t slot_ = (size_t)(((b * NH + h) * DS + g) * SPL + s);
      if (c == g / HPL) { pml[2 * slot_] = m[g % HPL]; pml[2 * slot_ + 1] = l[g % HPL]; } } }
}
__device__ __forceinline__ void combine_row(const P& p, int row, int lane) {
  const int b = row >> 6, h = (row >> 3) & 7, q = row & 7, d0 = 2 * lane;
  const unsigned short* Qb = (const unsigned short*)(p.ws + WS_QB); const unsigned short* Kb = (const unsigned short*)(p.ws + WS_KB); const unsigned short* Vb = (const unsigned short*)(p.ws + WS_VB);
  const float* LF = (const float*)(p.ws + WS_LF); const float* po = (const float*)(p.ws + WS_PO); const float* pml = (const float*)(p.ws + WS_PML);
  const unsigned qw = *reinterpret_cast<const unsigned*>(Qb + (size_t)(MP + b * DS + q) * AW + h * HD + d0);
  const float q0 = __builtin_bit_cast(float, qw << 16), q1 = __builtin_bit_cast(float, qw & 0xffff0000u);
  float s2[DS], v0[DS], v1[DS]; float fsum = 0.f;
#pragma unroll
  for (int j = 0; j < DS; ++j) {
    fsum += LF[(size_t)(MP + b * DS + j) * NH + h];
    const unsigned kw = *reinterpret_cast<const unsigned*>(Kb + (size_t)(MP + b * DS + j) * AW + h * HD + d0);
    const unsigned vw = *reinterpret_cast<const unsigned*>(Vb + (size_t)(MP + b * DS + j) * AW + h * HD + d0);
    v0[j] = __builtin_bit_cast(float, vw << 16); v1[j] = __builtin_bit_cast(float, vw & 0xffff0000u);
    const float dt = wave_sum(q0 * __builtin_bit_cast(float, kw << 16) + q1 * __builtin_bit_cast(float, kw & 0xffff0000u));
    s2[j] = (j <= q) ? dt * C2 - fsum * LOG2E : -INFINITY;
  }
  const size_t slot0 = (size_t)row * SPL;
  float Mx = -INFINITY;
#pragma unroll
  for (int s = 0; s < SPL; ++s) Mx = fmaxf(Mx, pml[2 * (slot0 + s)]);
#pragma unroll
  for (int j = 0; j < DS; ++j) Mx = fmaxf(Mx, s2[j]);
  float L = 0.f, o0 = 0.f, o1 = 0.f;
#pragma unroll
  for (int s = 0; s < SPL; ++s) { const float ls = pml[2 * (slot0 + s) + 1], w = (ls > 0.f) ? __builtin_amdgcn_exp2f(pml[2 * (slot0 + s)] - Mx) : 0.f;
    const float2 a = *reinterpret_cast<const float2*>(po + (slot0 + s) * HD + d0); L = fmaf(w, ls, L); o0 = fmaf(w, a.x, o0); o1 = fmaf(w, a.y, o1); }
#pragma unroll
  for (int j = 0; j < DS; ++j) { const float pj = __builtin_amdgcn_exp2f(s2[j] - Mx); L += pj; o0 = fmaf(pj, v0[j], o0); o1 = fmaf(pj, v1[j], o1); }
  const float inv = 1.f / L;
  *reinterpret_cast<unsigned*>((unsigned short*)(p.ws + WS_ASB) + (size_t)(MP + b * DS + q) * D + h * HD + d0) = pk2(o0 * inv, o1 * inv);
}
}
constexpr int ATT_NP = 136, ATT_MAXB = 2;
__device__ const short ATT_SCHED[ATT_NP][ATT_MAXB] = {
  {255,-1},
  {239,-1},
  {223,-1},
  {207,-1},
  {191,-1},
  {175,-1},
  {159,-1},
  {143,-1},
  {127,-1},
  {111,-1},
  {95,-1},
  {79,-1},
  {63,-1},
  {47,-1},
  {31,-1},
  {15,-1},
  {254,240},
  {238,224},
  {222,208},
  {206,192},
  {190,176},
  {174,160},
  {158,144},
  {142,128},
  {126,112},
  {110,96},
  {94,80},
  {78,64},
  {62,48},
  {46,32},
  {30,16},
  {14,0},
  {253,241},
  {237,225},
  {221,209},
  {205,193},
  {189,177},
  {173,161},
  {157,145},
  {141,129},
  {125,113},
  {109,97},
  {93,81},
  {77,65},
  {61,49},
  {45,33},
  {29,17},
  {13,1},
  {252,242},
  {236,226},
  {220,210},
  {204,194},
  {188,178},
  {172,162},
  {156,146},
  {140,130},
  {124,114},
  {108,98},
  {92,82},
  {76,66},
  {60,50},
  {44,34},
  {28,18},
  {12,2},
  {251,243},
  {235,227},
  {219,211},
  {203,195},
  {187,179},
  {171,163},
  {155,147},
  {139,131},
  {123,115},
  {107,99},
  {91,83},
  {75,67},
  {59,51},
  {43,35},
  {27,19},
  {11,3},
  {250,244},
  {234,228},
  {218,212},
  {202,196},
  {186,180},
  {170,164},
  {154,148},
  {138,132},
  {122,116},
  {106,100},
  {90,84},
  {74,68},
  {58,52},
  {42,36},
  {26,20},
  {10,4},
  {249,245},
  {233,229},
  {217,213},
  {201,197},
  {185,181},
  {169,165},
  {153,149},
  {137,133},
  {121,117},
  {105,101},
  {89,85},
  {73,69},
  {57,53},
  {41,37},
  {25,21},
  {9,5},
  {248,246},
  {232,230},
  {216,214},
  {200,198},
  {184,182},
  {168,166},
  {152,150},
  {136,134},
  {120,118},
  {104,102},
  {88,86},
  {72,70},
  {56,54},
  {40,38},
  {24,22},
  {8,6},
  {247,119},
  {231,103},
  {215,87},
  {199,71},
  {183,55},
  {167,39},
  {151,23},
  {135,7}
};
__device__ __forceinline__ void phase_attn_prompt(const P& p, char* lds, int wg, const int tid) {
    typedef att::BlockRef<att::bf16, att::bf16> BR;
    const __amdgpu_buffer_rsrc_t rs = __builtin_amdgcn_make_buffer_rsrc((void*)p.ws, (short)0, 0x7fffffff, 0x00020000);
    constexpr int NQB = SEQ / att::QB;
    constexpr int W = 1 << 30;
    auto mk = [&](int id) { const int bh = id / NQB, qb = id % NQB, b = bh / NH, h = bh % NH; const unsigned row0 = (unsigned)(b * SEQ + qb * att::QB);
        BR r; r.Q = (unsigned)WS_QB + (row0 * att::RS + h * HD) * 2u; r.O = (unsigned)WS_ASB + (row0 * att::OS + h * HD) * 2u;
        r.K = (unsigned)WS_KB + ((unsigned)(b * SEQ) * att::RS + h * HD) * 2u; r.V = (unsigned)WS_VB + ((unsigned)(b * SEQ) * att::RS + h * HD) * 2u;
        r.F = (unsigned)WS_FC + (unsigned)(bh * SEQ) * 4u; r.P0 = qb * att::QB; return r; };
    int slot = 0;
    BR cur = mk(ATT_SCHED[wg][0]);
    att::Seam<att::bf16> S;
    att::causal_swa_prime<att::bf16, att::bf16>(cur, W, lds, S, rs, tid);
    for (;;) {
        const int nid = (slot + 1 < ATT_MAXB) ? (int)ATT_SCHED[wg][slot + 1] : -1;
        const bool last = nid < 0;
        const BR nxt = last ? cur : mk(nid);
        att::causal_swa_block<att::bf16, att::bf16>(cur, nxt, SEQ, W, lds, S, rs, tid);
        if (last) break;
        cur = nxt; ++slot;
    }
}
__global__ void __launch_bounds__(NWAVES * 64, 2) mega(P p) {
#define LOADP() do { int l_; asm volatile("v_mbcnt_lo_u32_b32 %0, -1, 0\n\tv_mbcnt_hi_u32_b32 %0, -1, %0" : "=v"(l_)); F.lane = l_; F.tid = F.wave * 64 + l_; } while (0)
    extern __shared__ __attribute__((aligned(16))) unsigned char lds[];
    Frame F;
    F.lds = (LAS unsigned char*)lds; F.tid = threadIdx.x; F.lane = F.tid & 63; F.wave = __builtin_amdgcn_readfirstlane(F.tid >> 6); F.G = gridDim.x; F.bid = blockIdx.x;
    volatile LAS unsigned* MISC = (volatile LAS unsigned*)(F.lds + MISC_OFF);
    for (int u = F.tid; u < (LDS_BYTES - LDSCTL_OFF) / 4; u += NWAVES * 64) ((LAS unsigned*)(F.lds + LDSCTL_OFF))[u] = 0u;
    __syncthreads();
    XcdBarrier bar = xcd_barrier_post((unsigned*)p.ws + CW_BAR, MISC + 8, F.tid);
#ifndef PHMASK
#define PHMASK 0xFFFF
#endif
#define IN(k) ((PHMASK >> (k)) & 1)
#define BOTH(k) (IN(k) && IN((k) + 1))
    if (IN(0)) { LOADP(); p0_prologue(p, F); __syncthreads(); }
    if (IN(1)) { LOADP(); phase_l0(p, F, bar.bar); if (BOTH(1)) xcd_barrier(bar, F.tid); }
    if (IN(2)) { LOADP();
        if (F.bid < NB * NH) scan_fc(p, F, F.bid);
        { SEpi1 E{&p}; skinny_gemm<4>(F, (const bf16*)(p.ws + WS_HB) + (size_t)MP * D, (const bf16*)(p.ws + WS_W1T), N1, D, (unsigned*)p.ws + CW_SK + 0 * 1024, p.ws, WS_SPART, E); }
        pg8::Gemm g{(const bf16*)(p.ws + WS_HB), (const bf16*)(p.ws + WS_W1T), MP, N1, D}; pg8::StaticOrder S; S.init(MP, N1, F.G, F.bid);
        pg8::EpiQKVU E{(bf16*)(p.ws + WS_QB), (bf16*)(p.ws + WS_KB), (bf16*)(p.ws + WS_VB), (bf16*)(p.ws + WS_UB), p.out + O_KP, p.out + O_VP, nullptr, nullptr};
        pg8::gemm_phase<pg8::EpiQKVU, pg8::StaticOrder, true, true>(F.lds + RING_OFF, g, S, E, F.tid);
        if (BOTH(2)) xcd_barrier(bar, F.tid);
    }
    if (IN(3)) { LOADP();
        if (F.G == 256 && F.bid < ATT_NP) { ssm::Tab T; const int g = (F.bid * NWAVES + F.wave) % NG; ssm::load_tab<false>(p, g, F.lane, T);
            for (int u = F.bid * NWAVES + F.wave; u < NG * ssm::NCH; u += ATT_NP * NWAVES) ssm::unit<0>(p, T, g, u / NG, F.lane, F.lds);
            VM_WAIT(); __syncthreads();
            if (F.tid == 0) { __builtin_amdgcn_fence(__ATOMIC_RELEASE, "agent"); VM_WAIT(); (void)xb_add((unsigned*)p.ws + CW_SSMA, 1u); } }
        if (F.G == 256) {
            if (F.bid < ATT_NP) {
                phase_attn_prompt(p, (char*)lds, F.bid, F.tid);
                LOADP();
                if (F.tid == 0) { XB_SPIN(xb_ld((unsigned*)p.ws + CW_SSMA) < (unsigned)ATT_NP, bar.bar); __builtin_amdgcn_fence(__ATOMIC_ACQUIRE, "agent"); VM_WAIT(); }
                __syncthreads();
                LAS unsigned char* img = F.lds + F.wave * ssm::WIMG;
                static_assert((ATT_NP * NWAVES) % NG == 0, "a wave's S5 units must share one group");
                ssm::Tab T; const int g = (F.bid * NWAVES + F.wave) % NG; ssm::load_tab<true>(p, g, F.lane, T);
                for (int u = F.bid * NWAVES + F.wave; u < NG * ssm::NCH + NG * (DB / 2); u += ATT_NP * NWAVES) {
                    if (u < NG * ssm::NCH) ssm::unit<1>(p, T, g, u / NG, F.lane, img);
                    else ssm::unit<2>(p, T, g, (u - NG * ssm::NCH) / NG, F.lane, img); }
            } else { const int idx = F.bid - ATT_NP; dec::split_wave(p, idx / dec::SPL, idx % dec::SPL, F.wave, F.lane, (float*)(lds + DEC_PEX_OFF) + F.wave * 768, F.lds + F.wave * 16384); }
        }
        if (BOTH(3)) xcd_barrier(bar, F.tid);
    }
    if (IN(4)) { LOADP();
        for (int row = F.bid * NWAVES + F.wave; row < DB * NH * DS; row += F.G * NWAVES) dec::combine_row(p, row, F.lane);
        if (BOTH(4)) xcd_barrier(bar, F.tid);
    }
    if (IN(5)) { LOADP();
        const bf16* ASB = (const bf16*)(p.ws + WS_ASB);
        { SEpiRes<true> E{&p, p.xs, 2}; skinny_gemm<2>(F, ASB + (size_t)MP * D, (const bf16*)(p.ws + WS_W2T), D, D, (unsigned*)p.ws + CW_SK + 1 * 1024, p.ws, WS_SPART, E); }
        pg8::Gemm g{ASB, (const bf16*)(p.ws + WS_W2T), MP, D, D}; pg8::StaticOrder S; S.init(MP, D, F.G, F.bid);
        pg8::EpiRes<true> E{p.xp, modp(p, 0, 2), (bf16*)(p.ws + WS_T)};
        pg8::gemm_phase<pg8::EpiRes<true>, pg8::StaticOrder, false, true>(F.lds + RING_OFF, g, S, E, F.tid);
        if (BOTH(5)) xcd_barrier(bar, F.tid);
    }
    if (IN(6)) { LOADP(); phase_l1(p, F); if (BOTH(6)) xcd_barrier(bar, F.tid); }
    if (IN(7)) { LOADP();
        { SEpiRelu2 E{&p}; skinny_gemm<8>(F, (const bf16*)(p.ws + WS_HB) + (size_t)MP * D, (const bf16*)(p.ws + WS_W3T), DFF, D, (unsigned*)p.ws + CW_SK + 2 * 1024, p.ws, WS_SPART, E); }
        pg8::Gemm g{(const bf16*)(p.ws + WS_HB), (const bf16*)(p.ws + WS_W3T), MP, DFF, D}; pg8::StaticOrder S; S.init(MP, DFF, F.G, F.bid);
        pg8::EpiRelu2 E{(bf16*)(p.ws + WS_AB), DFF};
        pg8::gemm_phase<pg8::EpiRelu2, pg8::StaticOrder, true, true>(F.lds + RING_OFF, g, S, E, F.tid);
        if (BOTH(7)) xcd_barrier(bar, F.tid);
    }
    if (IN(8)) { LOADP();
        const bf16* AB = (const bf16*)(p.ws + WS_AB); const bf16* X1 = (const bf16*)(p.ws + WS_X1);
        { SEpiRes<false> E{&p, X1 + (size_t)MP * D, 5}; skinny_gemm<8>(F, AB + (size_t)MP * DFF, (const bf16*)(p.ws + WS_W4T), D, DFF, (unsigned*)p.ws + CW_SK + 3 * 1024, p.ws, WS_SPART, E); }
        pg8::Gemm g{AB, (const bf16*)(p.ws + WS_W4T), MP, D, DFF}; pg8::StaticOrder S; S.init(MP, D, F.G, F.bid);
        pg8::EpiRes<false> E{X1, modp(p, 0, 5), (bf16*)(p.ws + WS_T)};
        pg8::gemm_phase<pg8::EpiRes<false>, pg8::StaticOrder, false, true>(F.lds + RING_OFF, g, S, E, F.tid);
        if (BOTH(8)) xcd_barrier(bar, F.tid);
    }
    if (IN(9)) { LOADP(); phase_l2(p, F); }
#undef IN
#undef BOTH
}
extern "C" void kernel_launch(void* const* d_in, const int* in_sizes, int n_in, void* d_out, int out_size, void* d_ws, size_t ws_size, hipStream_t stream) {
    static int grid = 0;
    if (grid == 0) {
        if (n_in != 31 || out_size != (int)O_END || ws_size < WS_END) { fprintf(stderr, "kernel_launch: unexpected shapes\n"); grid = -1; return; }
        int dev = 0, cus = 0;
        if (hipGetDevice(&dev) != hipSuccess || hipDeviceGetAttribute(&cus, hipDeviceAttributeMultiprocessorCount, dev) != hipSuccess) { grid = -1; return; }
        if (hipFuncSetAttribute((const void*)mega, hipFuncAttributeMaxDynamicSharedMemorySize, LDS_BYTES) != hipSuccess) { fprintf(stderr, "kernel_launch: hipFuncSetAttribute failed\n"); grid = -1; return; }
        int per_cu = 0; (void)hipOccupancyMaxActiveBlocksPerMultiprocessor(&per_cu, (const void*)mega, NWAVES * 64, LDS_BYTES); (void)hipGetLastError();
        if (cus != 256) fprintf(stderr, "kernel_launch: the phase programme is dealt for 256 CUs (device reports %d)\n", cus);
        grid = 256;
    }
    if (grid < 0) return;
    P p{};
    p.xp = (const float*)d_in[0]; p.xs = (const float*)d_in[1]; p.cp = (const float*)d_in[2]; p.cs = (const float*)d_in[3];
    p.ck = (const float*)d_in[4]; p.cv = (const float*)d_in[5]; p.clf = (const float*)d_in[6]; p.sre = (const float*)d_in[7]; p.sim = (const float*)d_in[8];
    p.pt = (const int*)d_in[9]; p.w_ada = (const float*)d_in[10]; p.b_ada = (const float*)d_in[11]; p.w_in = (const float*)d_in[12]; p.b_f = (const float*)d_in[13];
    p.w_o = (const float*)d_in[14]; p.a_re = (const float*)d_in[15]; p.a_im = (const float*)d_in[16]; p.log_dt = (const float*)d_in[17];
    p.b_re = (const float*)d_in[18]; p.b_im = (const float*)d_in[19]; p.c_re = (const float*)d_in[20]; p.c_im = (const float*)d_in[21];
    p.d_skip = (const float*)d_in[22]; p.w_glu = (const float*)d_in[23]; p.b_glu = (const float*)d_in[24]; p.ln1_g = (const float*)d_in[25]; p.ln1_b = (const float*)d_in[26];
    p.w_up = (const float*)d_in[27]; p.w_down = (const float*)d_in[28]; p.ln2_g = (const float*)d_in[29]; p.ln2_b = (const float*)d_in[30];
    p.out = (float*)d_out; p.ws = (unsigned char*)d_ws;
    (void)hipMemsetAsync((char*)d_ws + WS_CTL, 0, CTL_ZERO_BYTES, stream);
    p.ph_lo = 0; p.ph_hi = 10; p.li = 0; p.pad = 0;
    hipLaunchKernelGGL(mega, dim3(grid), dim3(NWAVES * 64), LDS_BYTES, stream, p);
    (void)in_sizes;
}
```

```cpp
#include <hip/hip_runtime.h>
#include <cstdint>
#include <cstdio>
#include <cmath>

constexpr int D = 2048, NB = 2, SEQ = 4096, DB = 8, DS = 8, PAST = 16384, PAGE = 128, NPG = PAST / PAGE;
constexpr int AW = 1024, SW = 1024, HD = 128, NH = 8, SG = 16, NG = 64, SP = 64, DFF = 8192, NMOD = 6;
constexpr int INC = 3 * AW + NH + SW;
constexpr int MP = NB * SEQ, MS = DB * DS, M = MP + MS;
constexpr int NBT = NB + DB;
constexpr int N1 = 3 * AW + SW;
constexpr float ALPHA = 1.189207115002721f;
constexpr float LN_EPS = 1e-5f;
constexpr float SCALE = 0.08838834764831845f;
constexpr size_t O_YP = 0, O_YS = O_YP + (size_t)MP * D, O_KP = O_YS + (size_t)MS * D, O_VP = O_KP + (size_t)MP * AW,
                 O_LFP = O_VP + (size_t)MP * AW, O_SRP = O_LFP + (size_t)MP * NH, O_SIP = O_SRP + NB * NG * SP,
                 O_KS = O_SIP + NB * NG * SP, O_VS = O_KS + (size_t)MS * AW, O_LFS = O_VS + (size_t)MS * AW,
                 O_SRS = O_LFS + MS * NH, O_SIS = O_SRS + DB * NG * SP, O_END = O_SIS + DB * NG * SP;
constexpr size_t MiB = 1u << 20;
constexpr size_t WS_CTL = 0, CTL_ZERO_BYTES = 1 * MiB;
constexpr size_t WS_MOD = 1 * MiB;
constexpr size_t WS_W1T = 2 * MiB;
constexpr size_t WS_W2T = 18 * MiB;
constexpr size_t WS_W3T = 26 * MiB;
constexpr size_t WS_W4T = 58 * MiB;
constexpr size_t WS_HB  = 90 * MiB;
constexpr size_t WS_QB  = 124 * MiB;
constexpr size_t WS_KB  = 141 * MiB;
constexpr size_t WS_VB  = 158 * MiB;
constexpr size_t WS_UB  = 175 * MiB;
constexpr size_t WS_LF  = 192 * MiB;
constexpr size_t WS_FC  = 193 * MiB;
constexpr size_t WS_DEC = 194 * MiB;
constexpr size_t WS_ASB = 199 * MiB;
constexpr size_t WS_T   = 233 * MiB;
constexpr size_t WS_X1  = 298 * MiB;
constexpr size_t WS_AB  = 363 * MiB;
constexpr size_t WS_Q   = 493 * MiB;
constexpr size_t WS_U   = 527 * MiB;
constexpr size_t WS_AS  = 561 * MiB;
constexpr size_t WS_SC  = 626 * MiB;
constexpr size_t WS_PO  = 660 * MiB;
constexpr size_t WS_PML = 665 * MiB;
constexpr size_t WS_LAM = 666 * MiB;
constexpr size_t WS_BB  = 667 * MiB;
constexpr size_t WS_CC  = 668 * MiB;
constexpr size_t WS_WG  = 669 * MiB;
constexpr size_t WS_SEND = 670 * MiB;
constexpr size_t WS_PART = 700 * MiB;
constexpr size_t WS_SPART = 704 * MiB;
constexpr size_t WS_END = 712 * MiB;

static_assert(WS_KB - WS_QB == 17 * MiB && WS_VB - WS_KB == 17 * MiB && WS_UB - WS_VB == 17 * MiB && WS_U - WS_Q == 34 * MiB && O_VP - O_KP == (size_t)MP * AW, "EpiQKVU pointer arithmetic");
struct P {
    const float *xp, *xs, *cp, *cs, *ck, *cv, *clf, *sre, *sim; const int* pt;
    const float *w_ada, *b_ada, *w_in, *b_f, *w_o, *a_re, *a_im, *log_dt, *b_re, *b_im, *c_re, *c_im, *d_skip, *w_glu, *b_glu,
                *ln1_g, *ln1_b, *w_up, *w_down, *ln2_g, *ln2_b;
    float* out; unsigned char* ws;
    int ph_lo, ph_hi, li, pad;
};
__device__ __forceinline__ const float* xrow(const P& p, int m) { return m < MP ? p.xp + (size_t)m * D : p.xs + (size_t)(m - MP) * D; }
__device__ __forceinline__ int brow(int m) { return m < MP ? m / SEQ : NB + (m - MP) / DS; }
__device__ __forceinline__ float* modp(const P& p, int b, int i) { return (float*)(p.ws + WS_MOD) + (size_t)b * NMOD * D + (size_t)i * D; }
__device__ __forceinline__ float log_sigmoid(float x) { return fminf(x, 0.f) - log1pf(__expf(-fabsf(x))); }

namespace pg8 {
#define PG8_LAS __attribute__((address_space(3)))
typedef unsigned short bf16_t;
typedef short bf16x8 __attribute__((ext_vector_type(8)));
typedef float f32x4 __attribute__((ext_vector_type(4)));
typedef unsigned u32x4 __attribute__((ext_vector_type(4)));
constexpr int BM = 256, BK = 64, HALF = 128, HTB = HALF * BK * 2  , STAGE_BYTES = 8 * HTB, NXCD = 8, WGM = 8;

__host__ __device__ __forceinline__ int lds_byte(int r, int c) { const int st = (r >> 4) * 2 + (c >> 5), rr = r & 15, cc = c & 31, ob = rr * 64 + cc * 2; return st * 1024 + (ob ^ (((ob >> 9) & 1) << 5)); }
__host__ __device__ __forceinline__ void stage_rc(int b, int& R, int& C) { const int st = b / 1024, sb = b % 1024, swz = sb ^ (((sb >> 9) & 1) << 5); R = (st >> 1) * 16 + swz / 64; C = (st & 1) * 32 + (swz % 64) / 2; }
__host__ __device__ __forceinline__ int perm32(int rho) { const int n = rho >> 4, i = rho & 15; return 8 * (i >> 2) + 4 * n + (i & 3); }

struct Unit { int pm, pn; };
struct Gemm { const bf16_t* A; const bf16_t* Bt; int M, N, K; };

struct StaticOrder {
    int nM, nN, nwg, G, c;
    __host__ __device__ void init(int M, int N, int G_, int c_) { nM = M / BM; nN = N / BM; nwg = nM * nN; G = G_; c = c_; }
    __host__ __device__ bool next(int i, Unit& u) const {
        const long L = (long)i * G + c; if (L >= nwg) return false;
        int wgid = (int)L; { const int q = nwg / NXCD, r = nwg % NXCD, xcd = wgid % NXCD, off = wgid / NXCD; wgid = (xcd < r ? xcd * (q + 1) : r * (q + 1) + (xcd - r) * q) + off; }
        const int nig = WGM * nN, gid = wgid / nig, fm = gid * WGM, gsz = (nM - fm) < WGM ? (nM - fm) : WGM;
        u.pm = fm + ((wgid % nig) % gsz); u.pn = (wgid % nig) / gsz; return true;
    }
    __device__ __forceinline__ void a_ready(const Unit&) const {}
    __device__ __forceinline__ void done(const Unit&) const {}
};

__device__ __forceinline__ unsigned cvt_pk_bf16(float lo, float hi) { unsigned r; asm volatile("v_cvt_pk_bf16_f32 %0, %1, %2" : "=v"(r) : "v"(lo), "v"(hi)); return r; }
typedef float f32x2 __attribute__((ext_vector_type(2)));
struct EpiQKVU {
    static constexpr bool PERM = true, AFTER_DRAIN = false;
    bf16_t *Qb, *Kb, *Vb, *Ub; float *outK, *outV; float *Qf, *Uf;
    __device__ __forceinline__ void operator()(const f32x4 (&acc)[2][2][4][2], const Unit& u, int wr, int wc, int fr, int fq) const {
        const int region = u.pn >> 2, colt = (u.pn & 3) * BM;
        const int row0 = u.pm * BM + wr * 64 + fr, col0 = colt + wc * 32 + 8 * fq;
        bf16_t* ob = Qb + (size_t)region * (17u << 19);
        float* of = (region == 1 || region == 2) ? outK + (size_t)(region - 1) * ((size_t)8192 * 1024) : (Qf ? Qf + (size_t)(region / 3) * (34u << 18) : nullptr);
#pragma unroll
        for (int ai = 0; ai < 2; ++ai)
#pragma unroll
            for (int m = 0; m < 4; ++m) { const size_t ro = (size_t)(row0 + ai * HALF + m * 16) * 1024 + col0;
#pragma unroll
                for (int bj = 0; bj < 2; ++bj) { const f32x4 v0 = acc[ai][bj][m][0], v1 = acc[ai][bj][m][1];
                    u32x4 w; w.x = cvt_pk_bf16(v0[0], v0[1]); w.y = cvt_pk_bf16(v0[2], v0[3]); w.z = cvt_pk_bf16(v1[0], v1[1]); w.w = cvt_pk_bf16(v1[2], v1[3]);
                    *(u32x4*)(ob + ro + bj * HALF) = w;
                    if (of) { __builtin_nontemporal_store(v0, (f32x4*)(of + ro + bj * HALF)); __builtin_nontemporal_store(v1, (f32x4*)(of + ro + bj * HALF + 4)); } } }
    }
};
template <bool BASE_F32> struct EpiRes {
    static constexpr bool PERM = true, AFTER_DRAIN = false;
    const void* base; const float* gate0; bf16_t* T;
    __device__ __forceinline__ void operator()(const f32x4 (&acc)[2][2][4][2], const Unit& u, int wr, int wc, int fr, int fq) const {
        const int row0 = u.pm * BM + wr * 64 + fr, col0 = u.pn * BM + wc * 32 + 8 * fq;
        const float* gb = gate0 + (size_t)((u.pm * BM) / 4096) * (6 * 2048);
#pragma unroll
        for (int bj = 0; bj < 2; ++bj) { const int col = col0 + bj * HALF; const f32x4 g0 = *(const f32x4*)(gb + col) + 1.0f, g1 = *(const f32x4*)(gb + col + 4) + 1.0f;
#pragma unroll
            for (int ai = 0; ai < 2; ++ai)
#pragma unroll
                for (int m = 0; m < 4; ++m) { const size_t off = (size_t)(row0 + ai * HALF + m * 16) * 2048 + col;
                    f32x4 b0, b1;
                    if (BASE_F32) { b0 = *(const f32x4*)((const float*)base + off); b1 = *(const f32x4*)((const float*)base + off + 4); }
                    else { const u32x4 w = *(const u32x4*)((const bf16_t*)base + off);
                        b0 = (f32x4){__builtin_bit_cast(float, w.x << 16), __builtin_bit_cast(float, w.x & 0xffff0000u), __builtin_bit_cast(float, w.y << 16), __builtin_bit_cast(float, w.y & 0xffff0000u)};
                        b1 = (f32x4){__builtin_bit_cast(float, w.z << 16), __builtin_bit_cast(float, w.z & 0xffff0000u), __builtin_bit_cast(float, w.w << 16), __builtin_bit_cast(float, w.w & 0xffff0000u)}; }
                    const f32x4 t0 = b0 * 1.189207115002721f + g0 * acc[ai][bj][m][0], t1 = b1 * 1.189207115002721f + g1 * acc[ai][bj][m][1];
                    u32x4 o; o.x = cvt_pk_bf16(t0[0], t0[1]); o.y = cvt_pk_bf16(t0[2], t0[3]); o.z = cvt_pk_bf16(t1[0], t1[1]); o.w = cvt_pk_bf16(t1[2], t1[3]);
                    *(u32x4*)(T + off) = o; } }
    }
};
struct EpiRelu2 {
    static constexpr bool PERM = true, AFTER_DRAIN = false;
    bf16_t* O; int ldc;
    __device__ __forceinline__ void operator()(const f32x4 (&acc)[2][2][4][2], const Unit& u, int wr, int wc, int fr, int fq) const {
        const int row0 = u.pm * BM + wr * 64 + fr, col0 = u.pn * BM + wc * 32 + 8 * fq;
#pragma unroll
        for (int ai = 0; ai < 2; ++ai)
#pragma unroll
            for (int m = 0; m < 4; ++m) { bf16_t* rowp = O + (size_t)(row0 + ai * HALF + m * 16) * ldc + col0;
#pragma unroll
                for (int bj = 0; bj < 2; ++bj) { f32x4 v0 = acc[ai][bj][m][0], v1 = acc[ai][bj][m][1];
                    v0 = __builtin_elementwise_max(v0, (f32x4){0.f, 0.f, 0.f, 0.f}); v1 = __builtin_elementwise_max(v1, (f32x4){0.f, 0.f, 0.f, 0.f}); v0 = v0 * v0; v1 = v1 * v1;
                    u32x4 w; w.x = cvt_pk_bf16(v0[0], v0[1]); w.y = cvt_pk_bf16(v0[2], v0[3]); w.z = cvt_pk_bf16(v1[0], v1[1]); w.w = cvt_pk_bf16(v1[2], v1[3]);
                    *(u32x4*)(rowp + bj * HALF) = w; } }
    }
};
template <class Epi, class Sched, bool ALIGN_EPI = false, bool SP2 = false>
__device__ __forceinline__ void gemm_phase(PG8_LAS unsigned char* lds, const Gemm g, const Sched& S, const Epi& E, const int tid_in) {
    const int tid = tid_in, wid = __builtin_amdgcn_readfirstlane(tid >> 6), lane = tid & 63, wr = wid >> 2, wc = wid & 3, fr = lane & 15, fq = lane >> 4;
    const int K = g.K, nt = K / BK;
    unsigned voffA[2], voffB[2];
#pragma unroll
    for (int i = 0; i < 2; ++i) { int R, C; stage_rc(tid * 16 + i * 8192, R, C); const int Rb = Epi::PERM ? ((R & ~31) + perm32(R & 31)) : R;
        voffA[i] = (unsigned)(R * K + C) * 2u; voffB[i] = (unsigned)(Rb * K + C) * 2u; }
    const size_t kstep = (size_t)(BK * 2);
    const size_t hstep = (size_t)HALF * K * 2;
    const size_t tstep = 2 * hstep;
    const unsigned ldsw = (unsigned)wid * 1024u;
    const int aoff = lds_byte(wr * 64 + fr, fq * 8), boff = lds_byte(wc * 32 + fr, fq * 8);
#define PG8_SA(b, h) (((b) * 2 + (h)) * HTB)
#define PG8_SB(b, h) ((4 + (b) * 2 + (h)) * HTB)
#define PG8_STAGE(bufoff, gbase, voff) do { _Pragma("unroll") for (int _i = 0; _i < 2; ++_i) \
        __builtin_amdgcn_global_load_lds((const unsigned*)((const char*)(gbase) + (voff)[_i]), (PG8_LAS unsigned*)(lds + (bufoff) + ldsw + _i * 8192), 16, 0, 0); } while (0)
#define PG8_LDA(dst, b, h) do { _Pragma("unroll") for (int m = 0; m < 4; ++m) _Pragma("unroll") for (int k = 0; k < 2; ++k) dst[m][k] = *(const PG8_LAS bf16x8*)(lds + PG8_SA(b, h) + aoff + m * 2048 + k * 1024); } while (0)
#define PG8_LDB(dst, b, h) do { _Pragma("unroll") for (int n = 0; n < 2; ++n) _Pragma("unroll") for (int k = 0; k < 2; ++k) dst[n][k] = *(const PG8_LAS bf16x8*)(lds + PG8_SB(b, h) + boff + n * 2048 + k * 1024); } while (0)
#define PG8_MMA(ai, bj, At, Bt) do { __builtin_amdgcn_s_setprio(1); _Pragma("unroll") for (int m = 0; m < 4; ++m) _Pragma("unroll") for (int n = 0; n < 2; ++n) _Pragma("unroll") for (int k = 0; k < 2; ++k) \
        acc[ai][bj][m][n] = __builtin_amdgcn_mfma_f32_16x16x32_bf16(Bt[n][k], At[m][k], acc[ai][bj][m][n], 0, 0, 0); __builtin_amdgcn_s_setprio(0); } while (0)
#define PG8_WAIT_V(n) asm volatile("s_waitcnt vmcnt(" #n ")" ::: "memory")
#define PG8_WAIT_L(n) asm volatile("s_waitcnt lgkmcnt(" #n ")" ::: "memory")
#define PG8_BAR __builtin_amdgcn_s_barrier()
#define PG8_SCHED __builtin_amdgcn_sched_barrier(0)
    Unit cur, nxt; int ui = 0;
    if (!S.next(0, cur)) return;
    f32x4 acc[2][2][4][2];
#pragma unroll
    for (int a = 0; a < 2; ++a)
#pragma unroll
        for (int b = 0; b < 2; ++b)
#pragma unroll
            for (int m = 0; m < 4; ++m)
#pragma unroll
                for (int n = 0; n < 2; ++n) acc[a][b][m][n] = (f32x4){0.f, 0.f, 0.f, 0.f};
    bf16x8 At[4][2], B0[2][2], B1[2][2];
    const char* cA = (const char*)g.A + (size_t)cur.pm * tstep; const char* cB = (const char*)g.Bt + (size_t)cur.pn * tstep;
    S.a_ready(cur);
    if constexpr (SP2) {
        PG8_STAGE(PG8_SB(0, 0), cB, voffB); PG8_STAGE(PG8_SB(0, 1), cB + hstep, voffB); PG8_STAGE(PG8_SA(0, 0), cA, voffA); PG8_STAGE(PG8_SA(0, 1), cA + hstep, voffA);
        if (wr == 1) PG8_BAR;
        PG8_WAIT_V(2); PG8_BAR;
        PG8_STAGE(PG8_SB(1, 0), cB + kstep, voffB); PG8_STAGE(PG8_SA(1, 0), cA + kstep, voffA); PG8_STAGE(PG8_SB(1, 1), cB + hstep + kstep, voffB);
        PG8_WAIT_V(6); PG8_BAR;
    } else {
        PG8_STAGE(PG8_SB(0, 0), cB, voffB); PG8_STAGE(PG8_SA(0, 0), cA, voffA); PG8_STAGE(PG8_SB(0, 1), cB + hstep, voffB); PG8_STAGE(PG8_SA(0, 1), cA + hstep, voffA);
        if (wr == 1) PG8_BAR;
        PG8_WAIT_V(4); PG8_BAR;
        PG8_STAGE(PG8_SB(1, 0), cB + kstep, voffB); PG8_STAGE(PG8_SA(1, 0), cA + kstep, voffA); PG8_STAGE(PG8_SB(1, 1), cB + hstep + kstep, voffB);
        PG8_WAIT_V(6); PG8_BAR;
    }
    for (;;) {
        const bool has_next = S.next(ui + 1, nxt);
        const char* nA = has_next ? (const char*)g.A + (size_t)nxt.pm * tstep : cA; const char* nB = has_next ? (const char*)g.Bt + (size_t)nxt.pn * tstep : cB;
        for (int t = 0; t < nt; t += 2) {
            const bool last = (t == nt - 2);
            const char* a1 = cA + (size_t)(t + 1) * kstep;
            const char* a2 = last ? nA : cA + (size_t)(t + 2) * kstep; const char* b2 = last ? nB : cB + (size_t)(t + 2) * kstep;
            const char* a3 = a2 + kstep; const char* b3 = b2 + kstep;
            if (last && has_next) S.a_ready(nxt);
            if constexpr (SP2) {
            PG8_LDB(B0, 0, 0); PG8_LDB(B1, 0, 1); PG8_SCHED; PG8_LDA(At, 0, 0); PG8_STAGE(PG8_SA(1, 1), a1 + hstep, voffA);
            PG8_WAIT_V(8); PG8_WAIT_L(0); PG8_BAR; PG8_MMA(0, 0, At, B0); PG8_MMA(0, 1, At, B1); PG8_BAR; PG8_SCHED;
            PG8_LDA(At, 0, 1); PG8_STAGE(PG8_SB(0, 0), b2, voffB); PG8_STAGE(PG8_SB(0, 1), b2 + hstep, voffB); PG8_STAGE(PG8_SA(0, 0), a2, voffA);
            PG8_WAIT_V(8); PG8_WAIT_L(0); PG8_BAR; PG8_MMA(1, 0, At, B0); PG8_MMA(1, 1, At, B1); PG8_BAR; PG8_SCHED;
            PG8_LDB(B0, 1, 0); PG8_LDB(B1, 1, 1); PG8_SCHED; PG8_LDA(At, 1, 0); PG8_STAGE(PG8_SA(0, 1), a2 + hstep, voffA);
            PG8_WAIT_V(8); PG8_WAIT_L(0); PG8_BAR; PG8_MMA(0, 0, At, B0); PG8_MMA(0, 1, At, B1); PG8_BAR; PG8_SCHED;
            PG8_LDA(At, 1, 1); PG8_STAGE(PG8_SB(1, 0), b3, voffB); PG8_STAGE(PG8_SB(1, 1), b3 + hstep, voffB); PG8_STAGE(PG8_SA(1, 0), a3, voffA);
            PG8_WAIT_V(8); PG8_WAIT_L(0); PG8_BAR; PG8_MMA(1, 0, At, B0); PG8_MMA(1, 1, At, B1); PG8_BAR; PG8_SCHED;
            } else {
            PG8_LDB(B0, 0, 0); PG8_SCHED; PG8_LDA(At, 0, 0); PG8_STAGE(PG8_SA(1, 1), a1 + hstep, voffA);
            PG8_WAIT_L(8); PG8_BAR; PG8_WAIT_L(0); PG8_MMA(0, 0, At, B0); PG8_BAR; PG8_SCHED;
            PG8_LDB(B1, 0, 1); PG8_STAGE(PG8_SB(0, 0), b2, voffB);
            PG8_BAR; PG8_WAIT_L(0); PG8_MMA(0, 1, At, B1); PG8_BAR;
            PG8_LDA(At, 0, 1); PG8_STAGE(PG8_SA(0, 0), a2, voffA);
            PG8_BAR; PG8_WAIT_L(0); PG8_MMA(1, 0, At, B0); PG8_BAR; PG8_SCHED;
            PG8_STAGE(PG8_SB(0, 1), b2 + hstep, voffB);
            PG8_WAIT_V(6); PG8_BAR; PG8_MMA(1, 1, At, B1); PG8_BAR;
            PG8_LDB(B0, 1, 0); PG8_SCHED; PG8_LDA(At, 1, 0); PG8_STAGE(PG8_SA(0, 1), a2 + hstep, voffA);
            PG8_WAIT_L(8); PG8_BAR; PG8_WAIT_L(0); PG8_MMA(0, 0, At, B0); PG8_BAR; PG8_SCHED;
            PG8_LDB(B1, 1, 1); PG8_STAGE(PG8_SB(1, 0), b3, voffB);
            PG8_BAR; PG8_WAIT_L(0); PG8_MMA(0, 1, At, B1); PG8_BAR;
            PG8_LDA(At, 1, 1); PG8_STAGE(PG8_SA(1, 0), a3, voffA);
            PG8_BAR; PG8_WAIT_L(0); PG8_MMA(1, 0, At, B0); PG8_BAR; PG8_SCHED;
            PG8_STAGE(PG8_SB(1, 1), b3 + hstep, voffB);
            PG8_WAIT_V(6); PG8_BAR; PG8_MMA(1, 1, At, B1); PG8_BAR;
            }
        }
        if constexpr (ALIGN_EPI) { if (wr == 0) PG8_BAR; }
        if constexpr (!Epi::AFTER_DRAIN) { E(acc, cur, wr, wc, fr, fq); S.done(cur); }
        if (!has_next) break;
#pragma unroll
        for (int a = 0; a < 2; ++a)
#pragma unroll
            for (int b = 0; b < 2; ++b)
#pragma unroll
                for (int m = 0; m < 4; ++m)
#pragma unroll
                    for (int n = 0; n < 2; ++n) acc[a][b][m][n] = (f32x4){0.f, 0.f, 0.f, 0.f};
        cur = nxt; cA = nA; cB = nB; ++ui;
        if constexpr (ALIGN_EPI) { if (wr == 1) PG8_BAR; }
    }
    PG8_WAIT_V(0);
    if constexpr (!ALIGN_EPI) { if (wr == 0) PG8_BAR; }
    PG8_BAR;
    if constexpr (Epi::AFTER_DRAIN) { E.fused(acc, cur, wr, wc, fr, fq, lds, wid, lane); S.done(cur); }
#undef PG8_SA
#undef PG8_SB
#undef PG8_STAGE
#undef PG8_LDA
#undef PG8_LDB
#undef PG8_MMA
#undef PG8_WAIT_V
#undef PG8_WAIT_L
#undef PG8_BAR
#undef PG8_SCHED
}
}
constexpr int NWAVES = 8;
constexpr int RING_OFF = 0, RING_BYTES = 131072;
constexpr int LDSCTL_OFF = RING_BYTES, MISC_OFF = LDSCTL_OFF + 320;
constexpr int LDS_BYTES = 163840;
constexpr int DEC_PEX_OFF = 132096;
constexpr int CW_TMO = 0, CW_CODE = 1, CW_MOD = 1024, CW_SSMA = 2048, CW_BAR = 4096, CW_SK = 16384;

#define GAS __attribute__((address_space(1)))
#define LAS __attribute__((address_space(3)))
typedef unsigned short bf16;
typedef unsigned v4u __attribute__((ext_vector_type(4)));
typedef unsigned v2u __attribute__((ext_vector_type(2)));
typedef float f32x4 __attribute__((ext_vector_type(4)));
typedef float f32x2 __attribute__((ext_vector_type(2)));
typedef short bf16x8 __attribute__((ext_vector_type(8)));
typedef GAS unsigned gu32;
#define RLX_AGENT __ATOMIC_RELAXED, __HIP_MEMORY_SCOPE_AGENT
#define LDS_WAIT() asm volatile("s_waitcnt lgkmcnt(0)" ::: "memory")
#define VM_WAIT() asm volatile("s_waitcnt vmcnt(0)" ::: "memory")
__device__ __forceinline__ unsigned f2bf(float f) { unsigned u = __builtin_bit_cast(unsigned, f); return (u + 0x7fffu + ((u >> 16) & 1u)) >> 16; }
typedef __bf16 pk_bf16x2 __attribute__((ext_vector_type(2)));
__device__ __forceinline__ unsigned pk2(float lo, float hi) { f32x2 v = {lo, hi}; return __builtin_bit_cast(unsigned, __builtin_convertvector(v, pk_bf16x2)); }
template <int CTRL> __device__ __forceinline__ float dpp_mov(float x) { return __builtin_bit_cast(float, __builtin_amdgcn_mov_dpp(__builtin_bit_cast(int, x), CTRL, 0xf, 0xf, true)); }
__device__ __forceinline__ float rows_sum(float x) {
    auto s = __builtin_amdgcn_permlane16_swap(__float_as_uint(x), __float_as_uint(x), false, false); x = __uint_as_float(s[0]) + __uint_as_float(s[1]);
    auto t = __builtin_amdgcn_permlane32_swap(__float_as_uint(x), __float_as_uint(x), false, false); return __uint_as_float(t[0]) + __uint_as_float(t[1]); }
__device__ __forceinline__ float wave_sum(float v) {
    v += dpp_mov<0xB1>(v);
    v += dpp_mov<0x4E>(v);
    v += dpp_mov<0x141>(v);
    v += dpp_mov<0x128>(v);
    return rows_sum(v);
}
#define XB_TMO      128
#define XB_XCNT(j)  (256  + 64 * (j))
#define XB_XSUB(j)  (1280 + 64 * (j))
#define XB_XGEN(j)  (2304 + 64 * (j))
#define XB_TOP      3328
#define XB_TOPGEN   3392
#define XCD_BAR_WORDS 3456
#define XB_SPIN_CAP (1u << 18)

__device__ __forceinline__ unsigned xb_ld(unsigned* p)              { return __hip_atomic_load(p, __ATOMIC_RELAXED, __HIP_MEMORY_SCOPE_AGENT); }
__device__ __forceinline__ unsigned xb_add(unsigned* p, unsigned v) { return __hip_atomic_fetch_add(p, v, __ATOMIC_RELAXED, __HIP_MEMORY_SCOPE_AGENT); }
__device__ __forceinline__ unsigned xb_xcc_id() { return (unsigned)__builtin_amdgcn_s_getreg((3 << 11) | 20) & 0xFu; }
#define XB_SPIN(cond, bar) do { unsigned _sp = 0; while (cond) { __builtin_amdgcn_s_sleep(1); \
    if ((++_sp & 255u) == 0u) { if (xb_ld(&(bar)[XB_TMO])) break; if (_sp > XB_SPIN_CAP) { atomicAdd(&(bar)[XB_TMO], 1u); break; } } } } while (0)

struct XcdBarrier {
    unsigned* bar; unsigned x;
    volatile LAS unsigned* st;
};

__device__ __forceinline__ XcdBarrier xcd_barrier_post(unsigned* bar, volatile LAS unsigned* st, const int tid) {
    XcdBarrier b; b.bar = bar; b.x = xb_xcc_id(); b.st = st;
    if (tid == 0) (void)xb_add(&bar[XB_XCNT(b.x)], 1u);
    return b;
}
__device__ __forceinline__ void xcd_barrier_complete(unsigned* bar, unsigned x, unsigned& nloc, unsigned& nx) {
    const unsigned G = gridDim.x * gridDim.y * gridDim.z;
    unsigned sum, cnt, mine, sp = 0u;
    for (;;) {
        sum = 0u; cnt = 0u; mine = 0u;
#pragma unroll
        for (unsigned j = 0; j < 16; ++j) { const unsigned c = xb_ld(&bar[XB_XCNT(j)]); sum += c; cnt += (c > 0u) ? 1u : 0u; mine = (j == x) ? c : mine; }
        if (sum == G) break;
        __builtin_amdgcn_s_sleep(1);
        if ((++sp & 255u) == 0u) { if (xb_ld(&bar[XB_TMO])) break; if (sp > XB_SPIN_CAP) { atomicAdd(&bar[XB_TMO], 1u); break; } }
    }
    nloc = mine > 0u ? mine : 1u; nx = cnt > 0u ? cnt : 1u;
}

__device__ __forceinline__ void xcd_barrier(const XcdBarrier& b, const int tid) {
    asm volatile("s_waitcnt vmcnt(0)" ::: "memory");
    __syncthreads();
    if (tid == 0) {
        unsigned* bar = b.bar;
        __builtin_amdgcn_s_waitcnt(0);
        unsigned nloc = b.st[0], nx = b.st[1];
        if (nloc == 0u) { xcd_barrier_complete(bar, b.x, nloc, nx); b.st[0] = nloc; b.st[1] = nx; }
        const unsigned old = xb_add(&bar[XB_XSUB(b.x)], 1u);
        const unsigned gen = old / nloc;
        if (old + 1u == (gen + 1u) * nloc) {
            __builtin_amdgcn_fence(__ATOMIC_RELEASE, "agent");
            asm volatile("s_waitcnt vmcnt(0)" ::: "memory");
            const unsigned og = xb_add(&bar[XB_TOP], 1u);
            const unsigned tg = og / nx;
            if (og + 1u == (tg + 1u) * nx) xb_add(&bar[XB_TOPGEN], 1u);
            else XB_SPIN(xb_ld(&bar[XB_TOPGEN]) == tg, bar);
            __builtin_amdgcn_fence(__ATOMIC_ACQUIRE, "agent");
            xb_add(&bar[XB_XGEN(b.x)], 1u);
            asm volatile("s_waitcnt vmcnt(0)" ::: "memory");
        } else {
            XB_SPIN(xb_ld(&bar[XB_XGEN(b.x)]) == gen, bar);
            __builtin_amdgcn_fence(__ATOMIC_ACQUIRE, "agent");
            asm volatile("s_waitcnt vmcnt(0)" ::: "memory");
        }
    }
    __syncthreads();
}


struct Frame { LAS unsigned char* lds; int tid, lane, wave, G, bid; };

namespace ssm {
typedef short bf16x8 __attribute__((ext_vector_type(8)));
typedef short s16x4 __attribute__((ext_vector_type(4)));
typedef float f32x16 __attribute__((ext_vector_type(16)));
typedef float f32x4 __attribute__((ext_vector_type(4)));
typedef float f32x2 __attribute__((ext_vector_type(2)));
typedef __bf16 bf16x2_t __attribute__((ext_vector_type(2)));
typedef unsigned u32x4 __attribute__((ext_vector_type(4)));
typedef unsigned u32x2 __attribute__((ext_vector_type(2)));
typedef short v4i16_t __attribute__((ext_vector_type(4)));
constexpr int CH = 64, NCH = SEQ / CH;
constexpr int ROWB = 72, IMGB = 32 * ROWB, WIMG = 4 * IMGB;
#define MFMA32(a, b, c) __builtin_amdgcn_mfma_f32_32x32x16_bf16((a), (b), (c), 0, 0, 0)
__device__ __forceinline__ unsigned cvtpk_s(float lo, float hi) { f32x2 v = {lo, hi}; bf16x2_t b = __builtin_convertvector(v, bf16x2_t); return __builtin_bit_cast(unsigned, b); }
__device__ __forceinline__ float bf_lo(unsigned w) { return __builtin_bit_cast(float, w << 16); }
__device__ __forceinline__ float bf_hi(unsigned w) { return __builtin_bit_cast(float, w & 0xffff0000u); }
__device__ __forceinline__ float gelu_tanh_f(float x) { const float a = 1.5957691216057308f * (x + 0.044715f * x * x * x); return x / (1.f + __expf(-a)); }

__device__ __forceinline__ void build_tables(const P& p, int g, int lane) {
    float* LAM = (float*)(p.ws + WS_LAM) + (size_t)g * 128; unsigned short* BB = (unsigned short*)(p.ws + WS_BB) + (size_t)g * 128 * 16;
    unsigned short* CC = (unsigned short*)(p.ws + WS_CC) + (size_t)g * 16 * 128; unsigned short* WG = (unsigned short*)(p.ws + WS_WG) + (size_t)g * 512;
    const float are = p.a_re[g * SP + lane], aim = p.a_im[g * SP + lane], dt = expf(p.log_dt[g]);
    const float mag = expf(are * dt), lr = mag * cosf(aim * dt), li = mag * sinf(aim * dt);
    const float den = are * are + aim * aim, nre = lr - 1.f;
    const float kre = (nre * are + li * aim) / den, kim = (li * are - nre * aim) / den;
    LAM[lane] = lr; LAM[64 + lane] = li;
#pragma unroll
    for (int c = 0; c < SG; c += 2) {
        const float br0 = p.b_re[(size_t)(g * SP + lane) * SG + c], bi0 = p.b_im[(size_t)(g * SP + lane) * SG + c], br1 = p.b_re[(size_t)(g * SP + lane) * SG + c + 1], bi1 = p.b_im[(size_t)(g * SP + lane) * SG + c + 1];
        *(unsigned*)(BB + (size_t)lane * 16 + c) = pk2(kre * br0 - kim * bi0, kre * br1 - kim * bi1);
        *(unsigned*)(BB + (size_t)(64 + lane) * 16 + c) = pk2(kre * bi0 + kim * br0, kre * bi1 + kim * br1);
    }
#pragma unroll
    for (int co = 0; co < SG; ++co) { CC[co * 128 + lane] = (unsigned short)f2bf(p.c_re[(size_t)(g * SG + co) * SP + lane]); CC[co * 128 + 64 + lane] = (unsigned short)f2bf(-p.c_im[(size_t)(g * SG + co) * SP + lane]); }
#pragma unroll
    for (int i = 0; i < 8; ++i) { const int idx = lane * 8 + i, j = idx & 7, e = (idx >> 3) & 31, h = idx >> 8, co = 8 * (j >> 2) + 4 * h + (j & 3);
        WG[idx] = (unsigned short)f2bf(p.w_glu[(size_t)(g * SG + co) * 2 * SG + e]); }
}
struct Tab { float lr[2], li[2]; bf16x8 bfrag[4]; bf16x8 ccfrag[8]; bf16x8 wgfrag; f32x4 dsk[2], bgv[2], bgg[2]; };
template <bool OUT>
__device__ __forceinline__ void load_tab(const P& p, int g, int lane, Tab& T) {
    const int c32 = lane & 31, hi = lane >> 5;
    const float* LAM = (const float*)(p.ws + WS_LAM) + (size_t)g * 128; const unsigned short* BB = (const unsigned short*)(p.ws + WS_BB) + (size_t)g * 128 * 16;
#pragma unroll
    for (int pb = 0; pb < 2; ++pb) { T.lr[pb] = LAM[c32 + 32 * pb]; T.li[pb] = LAM[64 + c32 + 32 * pb]; }
#pragma unroll
    for (int cb = 0; cb < 4; ++cb) T.bfrag[cb] = *(const bf16x8*)(BB + (size_t)(32 * cb + c32) * 16 + 8 * hi);
    if (OUT) {
        const unsigned short* CC = (const unsigned short*)(p.ws + WS_CC) + (size_t)g * 16 * 128; const unsigned short* WG = (const unsigned short*)(p.ws + WS_WG) + (size_t)g * 512;
#pragma unroll
        for (int s = 0; s < 8; ++s) { bf16x8 v = {0, 0, 0, 0, 0, 0, 0, 0}; if (c32 < 16) v = *(const bf16x8*)(CC + (size_t)c32 * 128 + 16 * s + 8 * hi); T.ccfrag[s] = v; }
        T.wgfrag = *(const bf16x8*)(WG + (size_t)(hi * 32 + c32) * 8);
#pragma unroll
        for (int q = 0; q < 2; ++q) { T.dsk[q] = *(const f32x4*)(p.d_skip + g * SG + 8 * q + 4 * hi); T.bgv[q] = *(const f32x4*)(p.b_glu + g * 2 * SG + 8 * q + 4 * hi); T.bgg[q] = *(const f32x4*)(p.b_glu + g * 2 * SG + SG + 8 * q + 4 * hi); }
    }
}
template <int MODE>
__device__ __forceinline__ void unit(const P& p, const Tab& T, int g, int cidx  , int lane, LAS unsigned char* img) {
    const int c32 = lane & 31, hi = lane >> 5;
    const unsigned short* Ub = (const unsigned short*)(p.ws + WS_UB);
    float hr[2], hm[2];
    const float (&lr)[2] = T.lr; const float (&li)[2] = T.li; const bf16x8 (&bfrag)[4] = T.bfrag;
#pragma unroll
    for (int pb = 0; pb < 2; ++pb) { hr[pb] = 0.f; hm[pb] = 0.f; }
    const int th = (c32 >> 2) & 1, tr = (c32 & 3) + 4 * (c32 >> 3);
    int rbA, rbD;
    if (MODE == 2) { rbA = MP + (cidx + 4 * th) * DS; rbD = MP + (cidx + 4 * hi) * DS; } else { rbA = th * SEQ + cidx * CH; rbD = hi * SEQ + cidx * CH; }
    if (MODE == 1 && cidx > 0) {
        float pr[2], pi[2];
#pragma unroll
        for (int pb = 0; pb < 2; ++pb) { float a = lr[pb], b = li[pb];
#pragma unroll
            for (int k = 0; k < 6; ++k) { const float na = a * a - b * b, nb = 2.f * a * b; a = na; b = nb; }
            pr[pb] = a; pi[pb] = b; }
        const float* S = (const float*)(p.ws + WS_SEND) + ((size_t)(hi * NG + g) * NCH) * 128 + c32;
        for (int j0 = 0; j0 < cidx; j0 += 8) {
            float sv[8][4];
#pragma unroll
            for (int jj = 0; jj < 8; ++jj) { const int j = (j0 + jj < cidx) ? j0 + jj : cidx - 1;
#pragma unroll
                for (int pb = 0; pb < 2; ++pb) { sv[jj][pb] = S[(size_t)j * 128 + 32 * pb]; sv[jj][2 + pb] = S[(size_t)j * 128 + 64 + 32 * pb]; } }
#pragma unroll
            for (int jj = 0; jj < 8; ++jj) if (j0 + jj < cidx) {
#pragma unroll
                for (int pb = 0; pb < 2; ++pb) { const float nr = pr[pb] * hr[pb] - pi[pb] * hm[pb] + sv[jj][pb], ni = pr[pb] * hm[pb] + pi[pb] * hr[pb] + sv[jj][2 + pb]; hr[pb] = nr; hm[pb] = ni; } }
        }
    }
    if (MODE == 2) {
#pragma unroll
        for (int pb = 0; pb < 2; ++pb) { hr[pb] = p.sre[(size_t)((cidx + 4 * hi) * NG + g) * SP + c32 + 32 * pb]; hm[pb] = p.sim[(size_t)((cidx + 4 * hi) * NG + g) * SP + c32 + 32 * pb]; }
    }
    const bf16x8 (&ccfrag)[8] = T.ccfrag; const bf16x8& wgfrag = T.wgfrag; const f32x4 (&dsk)[2] = T.dsk; const f32x4 (&bgv)[2] = T.bgv; const f32x4 (&bgg)[2] = T.bgg;
    float fr[2] = {0.f, 0.f}, fm[2] = {0.f, 0.f};
    constexpr int NSB = MODE == 2 ? 1 : CH / 16;
    const int trA = MODE == 2 ? (tr < DS ? tr : DS - 1) : tr;
    bf16x8 afn = *(const bf16x8*)(Ub + (size_t)(rbA + trA) * SW + g * SG + 8 * hi);
    u32x2 u0n = {0u, 0u}, u1n = {0u, 0u};
    if (MODE != 0) { u0n = *(const u32x2*)(Ub + (size_t)(rbA + trA) * SW + g * SG + 4 * hi); u1n = *(const u32x2*)(Ub + (size_t)(rbA + trA) * SW + g * SG + 8 + 4 * hi); }
    for (int sb = 0; sb < NSB; ++sb) {
        const bf16x8 afrag = afn; const u32x2 u0 = u0n, u1 = u1n;
        if (sb + 1 < NSB) { const size_t rn = (size_t)(rbA + 16 * (sb + 1) + trA) * SW + g * SG; afn = *(const bf16x8*)(Ub + rn + 8 * hi);
            if (MODE != 0) { u0n = *(const u32x2*)(Ub + rn + 4 * hi); u1n = *(const u32x2*)(Ub + rn + 8 + 4 * hi); } }
        const f32x16 zero = {0.f, 0.f, 0.f, 0.f, 0.f, 0.f, 0.f, 0.f, 0.f, 0.f, 0.f, 0.f, 0.f, 0.f, 0.f, 0.f};
        f32x16 bu[4];
#pragma unroll
        for (int cb = 0; cb < 4; ++cb) bu[cb] = MFMA32(afrag, bfrag[cb], zero);
#pragma unroll
        for (int r = 0; r < 16; ++r) {
#pragma unroll
            for (int pb = 0; pb < 2; ++pb) { const float nr = lr[pb] * hr[pb] - li[pb] * hm[pb] + bu[pb][r], ni = lr[pb] * hm[pb] + li[pb] * hr[pb] + bu[2 + pb][r];
                hr[pb] = nr; hm[pb] = ni; bu[pb][r] = nr; bu[2 + pb][r] = ni; }
            if (MODE == 2 && r == DS - 1) { fr[0] = hr[0]; fr[1] = hr[1]; fm[0] = hm[0]; fm[1] = hm[1]; }
        }
        if (MODE == 0) continue;
#pragma unroll
        for (int cb = 0; cb < 4; ++cb)
#pragma unroll
            for (int g4 = 0; g4 < 4; ++g4) { u32x2 w; w.x = cvtpk_s(bu[cb][4 * g4], bu[cb][4 * g4 + 1]); w.y = cvtpk_s(bu[cb][4 * g4 + 2], bu[cb][4 * g4 + 3]);
                *(LAS u32x2*)(img + cb * IMGB + c32 * ROWB + 8 * (2 * g4 + hi)) = w; }
        asm volatile("s_waitcnt lgkmcnt(0)" ::: "memory");
        f32x16 yt = zero;
        { const int i16 = lane & 15, q = i16 >> 2, pp = i16 & 3, blk = (lane >> 4) & 1;
#pragma unroll
          for (int s = 0; s < 8; ++s) { const LAS unsigned char* tp = img + (s >> 1) * IMGB + (16 * (s & 1) + 8 * hi + q) * ROWB + 8 * (4 * blk + pp);
              const s16x4 lo = __builtin_bit_cast(s16x4, __builtin_amdgcn_ds_read_tr16_b64_v4i16((LAS v4i16_t*)tp));
              const s16x4 hh = __builtin_bit_cast(s16x4, __builtin_amdgcn_ds_read_tr16_b64_v4i16((LAS v4i16_t*)(tp + 4 * ROWB)));
              const bf16x8 xa = {lo[0], lo[1], lo[2], lo[3], hh[0], hh[1], hh[2], hh[3]};
              yt = MFMA32(ccfrag[s], xa, yt); } }
        asm volatile("s_waitcnt lgkmcnt(0)" ::: "memory");
        const int tok = 16 * sb + tr; const bool live = MODE == 2 ? tr < DS : true;
        const size_t mrow = (size_t)(rbA + (MODE == 2 ? trA : tok));
        float z[8];
        z[0] = gelu_tanh_f(yt[0] + dsk[0][0] * bf_lo(u0.x)); z[1] = gelu_tanh_f(yt[1] + dsk[0][1] * bf_hi(u0.x)); z[2] = gelu_tanh_f(yt[2] + dsk[0][2] * bf_lo(u0.y)); z[3] = gelu_tanh_f(yt[3] + dsk[0][3] * bf_hi(u0.y));
        z[4] = gelu_tanh_f(yt[4] + dsk[1][0] * bf_lo(u1.x)); z[5] = gelu_tanh_f(yt[5] + dsk[1][1] * bf_hi(u1.x)); z[6] = gelu_tanh_f(yt[6] + dsk[1][2] * bf_lo(u1.y)); z[7] = gelu_tanh_f(yt[7] + dsk[1][3] * bf_hi(u1.y));
        u32x4 zp; zp.x = cvtpk_s(z[0], z[1]); zp.y = cvtpk_s(z[2], z[3]); zp.z = cvtpk_s(z[4], z[5]); zp.w = cvtpk_s(z[6], z[7]);
        const f32x16 zz = MFMA32(wgfrag, __builtin_bit_cast(bf16x8, zp), zero);
        float o[8];
#pragma unroll
        for (int i = 0; i < 8; ++i) { const float gate = zz[i + 8] + bgg[i >> 2][i & 3]; o[i] = (zz[i] + bgv[i >> 2][i & 3]) / (1.f + __expf(-gate)); }
        if (live) { unsigned short* ob = (unsigned short*)(p.ws + WS_ASB) + mrow * D + AW + g * SG;
            u32x2 w0, w1; w0.x = cvtpk_s(o[0], o[1]); w0.y = cvtpk_s(o[2], o[3]); w1.x = cvtpk_s(o[4], o[5]); w1.y = cvtpk_s(o[6], o[7]);
            *(u32x2*)(ob + 4 * hi) = w0; *(u32x2*)(ob + 8 + 4 * hi) = w1; }
    }
    if (MODE == 0) { float* S = (float*)(p.ws + WS_SEND) + ((size_t)(hi * NG + g) * NCH + cidx) * 128 + c32;
#pragma unroll
        for (int pb = 0; pb < 2; ++pb) { S[32 * pb] = hr[pb]; S[64 + 32 * pb] = hm[pb]; } }
    if (MODE == 1 && cidx == NCH - 1) {
#pragma unroll
        for (int pb = 0; pb < 2; ++pb) { p.out[O_SRP + (size_t)(hi * NG + g) * SP + c32 + 32 * pb] = hr[pb]; p.out[O_SIP + (size_t)(hi * NG + g) * SP + c32 + 32 * pb] = hm[pb]; } }
    if (MODE == 2) {
#pragma unroll
        for (int pb = 0; pb < 2; ++pb) { p.out[O_SRS + (size_t)((cidx + 4 * hi) * NG + g) * SP + c32 + 32 * pb] = fr[pb]; p.out[O_SIS + (size_t)((cidx + 4 * hi) * NG + g) * SP + c32 + 32 * pb] = fm[pb]; } }
}
#undef MFMA32
}

__device__ __forceinline__ float block_incl_scan(float tot, LAS float* sh, int tid, int lane, int wave, float& all) {
    float v = tot;
#pragma unroll
    for (int o = 1; o < 64; o <<= 1) { const float n = __shfl_up(v, o); if (lane >= o) v += n; }
    __syncthreads();
    if (lane == 63) sh[wave] = v;
    __syncthreads();
    float off = 0.f, a = 0.f;
#pragma unroll
    for (int w = 0; w < NWAVES; ++w) { const float t = sh[w]; if (w < wave) off += t; a += t; }
    all = a; return v + off;
}
__device__ __forceinline__ void scan_fc(const P& p, Frame& F, int bh) {
    const int b = bh / NH, h = bh % NH; const float* lf = (const float*)(p.ws + WS_LF); float* fc = (float*)(p.ws + WS_FC) + (size_t)bh * SEQ;
    float v[8]; float s = 0.f;
#pragma unroll
    for (int i = 0; i < 8; ++i) { s += lf[(size_t)(b * SEQ + F.tid * 8 + i) * NH + h]; v[i] = s; }
    float all; const float incl = block_incl_scan(s, (LAS float*)F.lds, F.tid, F.lane, F.wave, all); const float off = incl - s;
#pragma unroll
    for (int i = 0; i < 8; ++i) fc[F.tid * 8 + i] = off + v[i];
    __syncthreads();
}
__device__ __forceinline__ void scan_dec(const P& p, Frame& F, int bh) {
    const int b = bh / NH, h = bh % NH; float* dec = (float*)(p.ws + WS_DEC) + (size_t)bh * PAST;
    const int pos0 = F.tid * 32; const int pg = p.pt[b * NPG + pos0 / PAGE];
    const float* src = p.clf + ((size_t)pg * PAGE + (pos0 % PAGE)) * NH + h;
    float v[32]; float s = 0.f;
#pragma unroll
    for (int i = 31; i >= 0; --i) { v[i] = s; s += src[(size_t)i * NH]; }
    float all; const float incl = block_incl_scan(s, (LAS float*)F.lds, F.tid, F.lane, F.wave, all); const float off = all - incl;
#pragma unroll
    for (int i = 0; i < 32; ++i) dec[pos0 + i] = off + v[i];
    __syncthreads();
}

__device__ __forceinline__ void p0_transpose_item(const float* W, int ldw, int K, int ncols, bf16* WT, int row_off, int item, int lane) {
    const int nblk = ncols / 64, kb = item / nblk, nb = item % nblk, k0 = 64 * kb, n0 = 64 * nb, cq = lane & 15, rg = lane >> 4;
    const float* src = W + (size_t)(k0 + 8 * rg) * ldw + n0 + 4 * cq;
    f32x4 f[2][8];
#pragma unroll
    for (int h = 0; h < 2; ++h)
#pragma unroll
        for (int i = 0; i < 8; ++i) f[h][i] = __builtin_nontemporal_load((const f32x4*)(src + (size_t)(32 * h + i) * ldw));
    bf16* dst = WT + (size_t)(row_off + n0 + 4 * cq) * K + k0 + 8 * rg;
#pragma unroll
    for (int h = 0; h < 2; ++h)
#pragma unroll
        for (int e = 0; e < 4; ++e) { v4u o; o.x = pk2(f[h][0][e], f[h][1][e]); o.y = pk2(f[h][2][e], f[h][3][e]); o.z = pk2(f[h][4][e], f[h][5][e]); o.w = pk2(f[h][6][e], f[h][7][e]);
            *(GAS v4u*)(dst + (size_t)e * K + 32 * h) = o; }
}
__device__ __forceinline__ void p0_mod(const P& p, Frame& F) {
    LAS float* S = (LAS float*)F.lds;
    const int kc = F.bid / 24, nc = F.bid % 24;
    for (int idx = F.tid; idx < NBT * 256; idx += NWAVES * 64) { const int r = idx >> 8, k = idx & 255; const float c = r < NB ? p.cp[r * D + 256 * kc + k] : p.cs[(r - NB) * D + 256 * kc + k];
        S[k * 12 + r] = c / (1.f + expf(-c)); }
    __syncthreads();
    const int n0 = 512 * nc + 64 * F.wave, cg = F.lane & 15, rq = F.lane >> 4;
    f32x4 acc[NBT];
#pragma unroll
    for (int r = 0; r < NBT; ++r) acc[r] = (f32x4){0.f, 0.f, 0.f, 0.f};
    const float* wp = p.w_ada + (size_t)(256 * kc + rq) * (NMOD * D) + n0 + 4 * cg;
#pragma unroll 8
    for (int it = 0; it < 64; ++it) {
        const f32x4 wv = __builtin_nontemporal_load((const f32x4*)(wp + (size_t)(4 * it) * (NMOD * D)));
        const LAS float* sk = S + (4 * it + rq) * 12;
        const f32x4 s0 = *(const LAS f32x4*)sk, s1 = *(const LAS f32x4*)(sk + 4); const f32x2 s2 = *(const LAS f32x2*)(sk + 8);
        acc[0] += wv * s0[0]; acc[1] += wv * s0[1]; acc[2] += wv * s0[2]; acc[3] += wv * s0[3];
        acc[4] += wv * s1[0]; acc[5] += wv * s1[1]; acc[6] += wv * s1[2]; acc[7] += wv * s1[3];
        acc[8] += wv * s2[0]; acc[9] += wv * s2[1];
    }
#pragma unroll
    for (int r = 0; r < NBT; ++r)
#pragma unroll
        for (int e = 0; e < 4; ++e) acc[r][e] = rows_sum(acc[r][e]);
    if (rq == 0) { float* part = (float*)(p.ws + WS_PART) + (size_t)kc * NBT * NMOD * D + n0 + 4 * cg;
#pragma unroll
        for (int r = 0; r < NBT; ++r) *(f32x4*)(part + (size_t)r * NMOD * D) = acc[r]; }
    VM_WAIT(); __syncthreads();
    if (F.tid == 0) { __builtin_amdgcn_fence(__ATOMIC_RELEASE, "agent"); VM_WAIT(); (void)xb_add((unsigned*)p.ws + CW_MOD, 1u); }
}
__device__ __forceinline__ float mod_reduce(const P& p, int idx  ) {
    const float* part = (const float*)(p.ws + WS_PART) + idx; float v = p.b_ada[idx % (NMOD * D)];
#pragma unroll
    for (int kc = 0; kc < 8; ++kc) v += part[(size_t)kc * NBT * NMOD * D];
    return v;
}
__device__ __forceinline__ void p0_prologue(const P& p, Frame& F) {
    constexpr int NMODWG = NMOD * D / 64;
    if (F.bid < NMODWG) p0_mod(p, F);
    else if (F.G == 256) { scan_dec(p, F, F.bid - NMODWG);
        if (F.bid < NMODWG + 8) ssm::build_tables(p, (F.bid - NMODWG) * NWAVES + F.wave, F.lane); }
    bf16* W1T = (bf16*)(p.ws + WS_W1T); bf16* W2T = (bf16*)(p.ws + WS_W2T); bf16* W3T = (bf16*)(p.ws + WS_W3T); bf16* W4T = (bf16*)(p.ws + WS_W4T);
    constexpr int I_1A = (D / 64) * (3 * AW / 64), I_1B = (D / 64) * (SW / 64), I_2 = (D / 64) * (D / 64), I_3 = (D / 64) * (DFF / 64), I_4 = (DFF / 64) * (D / 64);
    constexpr int NITEMS = I_1A + I_1B + I_2 + I_3 + I_4;
    constexpr int TS = NMODWG * NWAVES * 2 + (256 - NMODWG) * NWAVES * 3;
    int slot0, nsl;
    int sstep = 1;
    if (F.G == 256) { sstep = NWAVES; if (F.bid < NMODWG) { slot0 = F.bid * NWAVES * 2 + F.wave; nsl = 2; } else { slot0 = NMODWG * NWAVES * 2 + (F.bid - NMODWG) * NWAVES * 3 + F.wave; nsl = 3; } }
    else { slot0 = F.bid * NWAVES + F.wave; nsl = 1; }
    const int stride = F.G == 256 ? TS : F.G * NWAVES;
    for (int sl = 0; sl < nsl; ++sl)
        for (int it = slot0 + sl * sstep; it < NITEMS; it += stride) {
            int r = it;
            if (r < I_1A) { p0_transpose_item(p.w_in, INC, D, 3 * AW, W1T, 0, r, F.lane); continue; } r -= I_1A;
            if (r < I_1B) { p0_transpose_item(p.w_in + 3 * AW + NH, INC, D, SW, W1T, 3 * AW, r, F.lane); continue; } r -= I_1B;
            if (r < I_2) { p0_transpose_item(p.w_o, D, D, D, W2T, 0, r, F.lane); continue; } r -= I_2;
            if (r < I_3) { p0_transpose_item(p.w_up, DFF, D, DFF, W3T, 0, r, F.lane); continue; } r -= I_3;
            p0_transpose_item(p.w_down, D, DFF, D, W4T, 0, r, F.lane);
        }
}
__device__ __forceinline__ void row_stats(const f32x4 (&v)[8], float& mean, float& rstd) {
    float s = 0.f;
#pragma unroll
    for (int j = 0; j < 8; ++j) s += (v[j][0] + v[j][1]) + (v[j][2] + v[j][3]);
    mean = wave_sum(s) * (1.f / D); float q = 0.f;
#pragma unroll
    for (int j = 0; j < 8; ++j) { const f32x4 d = v[j] - mean; q += (d[0] * d[0] + d[1] * d[1]) + (d[2] * d[2] + d[3] * d[3]); }
    rstd = 1.f / sqrtf(wave_sum(q) * (1.f / D) + LN_EPS);
}
__device__ __forceinline__ void phase_l0(const P& p, Frame& F, unsigned* tmo_bar) {
    LAS float* WF = (LAS float*)F.lds;
    LAS float* ML = (LAS float*)(F.lds + 65536);
#pragma unroll 8
    for (int idx = F.tid; idx < D * NH; idx += NWAVES * 64) { const int c = idx >> 3, hh = idx & 7;
        WF[((((c >> 8) * 4 + (c & 3)) * 2 + (hh >> 2)) * 64 + ((c & 255) >> 2)) * 4 + (hh & 3)] = p.w_in[(size_t)c * INC + 3 * AW + hh]; }
    if (F.tid == 0) { XB_SPIN(xb_ld((unsigned*)p.ws + CW_MOD) < (unsigned)(NMOD * D / 64), tmo_bar); __builtin_amdgcn_fence(__ATOMIC_ACQUIRE, "agent"); VM_WAIT(); }
    __syncthreads();
    { float* mod = (float*)(p.ws + WS_MOD);
      if (F.G == 256) { if (F.tid < 480) { const int idx = F.bid * 480 + F.tid; mod[idx] = mod_reduce(p, idx); } }
      else for (int idx = F.bid * NWAVES * 64 + F.tid; idx < NBT * NMOD * D; idx += F.G * NWAVES * 64) mod[idx] = mod_reduce(p, idx);
      const int nsel = (F.bid < DB) ? 3 : 2;
      for (int i0 = 0; i0 < nsel * 2 * D; i0 += 8 * NWAVES * 64) { float v[8];
#pragma unroll
          for (int k = 0; k < 8; ++k) { const int idx = i0 + k * NWAVES * 64 + F.tid, bsel = idx / (2 * D), rem = idx % (2 * D), b = bsel < 2 ? bsel : NB + F.bid; v[k] = mod_reduce(p, b * NMOD * D + rem); }
#pragma unroll
          for (int k = 0; k < 8; ++k) { const int idx = i0 + k * NWAVES * 64 + F.tid, rem = idx % (2 * D); ML[idx] = rem < D ? v[k] : 1.0f + v[k]; } } }
    __syncthreads();
    bf16* Hb = (bf16*)(p.ws + WS_HB); float* LF = (float*)(p.ws + WS_LF);
    const int gw = F.bid * NWAVES + F.wave, NGW = F.G * NWAVES;
    f32x4 nv[8];
    if (gw < M) { const GAS f32x4* xr = (const GAS f32x4*)xrow(p, gw) + F.lane;
#pragma unroll
        for (int j = 0; j < 8; ++j) nv[j] = xr[64 * j]; }
    for (int m = gw; m < M; m += NGW) {
        f32x4 v[8];
#pragma unroll
        for (int j = 0; j < 8; ++j) v[j] = nv[j];
        if (m + NGW < M) { const GAS f32x4* xr = (const GAS f32x4*)xrow(p, m + NGW) + F.lane;
#pragma unroll
            for (int j = 0; j < 8; ++j) nv[j] = xr[64 * j]; }
        float mean, rstd; row_stats(v, mean, rstd);
        const int bsel = m < MP ? m / SEQ : 2;
        const LAS f32x4* sh1 = (const LAS f32x4*)(ML + bsel * 2 * D) + F.lane; const LAS f32x4* sc1 = (const LAS f32x4*)(ML + bsel * 2 * D + D) + F.lane;
        GAS v2u* o8 = (GAS v2u*)(Hb + (size_t)m * D) + F.lane;
        f32x2 fp[4];
#pragma unroll
        for (int e = 0; e < 4; ++e) fp[e] = (f32x2){0.f, 0.f};
#pragma unroll
        for (int j = 0; j < 8; ++j) {
            const f32x4 h = (v[j] - mean) * rstd * sc1[64 * j] + sh1[64 * j];
            v2u o; o.x = pk2(h[0], h[1]); o.y = pk2(h[2], h[3]); o8[64 * j] = o;
            const LAS f32x4* wf = (const LAS f32x4*)WF + j * 512 + F.lane;
#pragma unroll
            for (int e = 0; e < 4; ++e) { const f32x4 w0 = wf[(2 * e) * 64], w1 = wf[(2 * e + 1) * 64]; const f32x2 hh = {h[e], h[e]};
                fp[0] += hh * (f32x2){w0[0], w0[1]}; fp[1] += hh * (f32x2){w0[2], w0[3]}; fp[2] += hh * (f32x2){w1[0], w1[1]}; fp[3] += hh * (f32x2){w1[2], w1[3]}; }
            asm volatile("" ::: "memory");
        }
        float fl[8];
#pragma unroll
        for (int e = 0; e < 8; ++e) fl[e] = wave_sum(fp[e >> 1][e & 1]);
        if (F.lane < 8) {
            float f = fl[0];
#pragma unroll
            for (int e = 1; e < 8; ++e) f = (F.lane == e) ? fl[e] : f;
            const float lf = log_sigmoid(f + p.b_f[F.lane]);
            LF[(size_t)m * NH + F.lane] = lf;
            if (m < MP) p.out[O_LFP + (size_t)m * NH + F.lane] = lf; else p.out[O_LFS + (size_t)(m - MP) * NH + F.lane] = lf;
        }
    }
    __syncthreads();
}
__device__ __forceinline__ f32x4 unpk4(v2u w) { return (f32x4){__builtin_bit_cast(float, w.x << 16), __builtin_bit_cast(float, w.x & 0xffff0000u), __builtin_bit_cast(float, w.y << 16), __builtin_bit_cast(float, w.y & 0xffff0000u)}; }
__device__ __forceinline__ void phase_l1(const P& p, Frame& F) {
    bf16* Hb = (bf16*)(p.ws + WS_HB); const bf16* T = (const bf16*)(p.ws + WS_T); bf16* X1 = (bf16*)(p.ws + WS_X1);
    const int gw = F.bid * NWAVES + F.wave, NGW = F.G * NWAVES;
    f32x4 g1[8], b1[8];
#pragma unroll
    for (int j = 0; j < 8; ++j) { g1[j] = ((const GAS f32x4*)p.ln1_g + F.lane)[64 * j]; b1[j] = ((const GAS f32x4*)p.ln1_b + F.lane)[64 * j]; }
    v2u nv[8];
    if (gw < M) { const GAS v2u* tr = (const GAS v2u*)(T + (size_t)gw * D) + F.lane;
#pragma unroll
        for (int j = 0; j < 8; ++j) nv[j] = tr[64 * j]; }
    for (int m = gw; m < M; m += NGW) {
        f32x4 v[8];
#pragma unroll
        for (int j = 0; j < 8; ++j) v[j] = unpk4(nv[j]);
        if (m + NGW < M) { const GAS v2u* tr = (const GAS v2u*)(T + (size_t)(m + NGW) * D) + F.lane;
#pragma unroll
            for (int j = 0; j < 8; ++j) nv[j] = tr[64 * j]; }
        const int b = brow(m);
        const GAS f32x4* sh2 = (const GAS f32x4*)modp(p, b, 3) + F.lane; const GAS f32x4* sc2 = (const GAS f32x4*)modp(p, b, 4) + F.lane;
        f32x4 s2[8], h2[8];
#pragma unroll
        for (int j = 0; j < 8; ++j) { s2[j] = sc2[64 * j]; h2[j] = sh2[64 * j]; }
        float mean, rstd; row_stats(v, mean, rstd);
        GAS v2u* xo = (GAS v2u*)(X1 + (size_t)m * D) + F.lane;
#pragma unroll
        for (int j = 0; j < 8; ++j) { v[j] = (v[j] - mean) * rstd * g1[j] + b1[j]; v2u o; o.x = pk2(v[j][0], v[j][1]); o.y = pk2(v[j][2], v[j][3]); xo[64 * j] = o; }
        row_stats(v, mean, rstd);
        GAS v2u* o8 = (GAS v2u*)(Hb + (size_t)m * D) + F.lane;
#pragma unroll
        for (int j = 0; j < 8; ++j) { const f32x4 h = (v[j] - mean) * rstd * (s2[j] + 1.0f) + h2[j];
            v2u o; o.x = pk2(h[0], h[1]); o.y = pk2(h[2], h[3]); o8[64 * j] = o; }
    }
}
__device__ __forceinline__ void phase_l2(const P& p, Frame& F) {
    const bf16* T = (const bf16*)(p.ws + WS_T);
    const int gw = F.bid * NWAVES + F.wave, NGW = F.G * NWAVES;
    f32x4 g2[8], b2[8];
#pragma unroll
    for (int j = 0; j < 8; ++j) { g2[j] = ((const GAS f32x4*)p.ln2_g + F.lane)[64 * j]; b2[j] = ((const GAS f32x4*)p.ln2_b + F.lane)[64 * j]; }
    v2u nv[8];
    if (gw < M) { const GAS v2u* tr = (const GAS v2u*)(T + (size_t)gw * D) + F.lane;
#pragma unroll
        for (int j = 0; j < 8; ++j) nv[j] = tr[64 * j]; }
    for (int m = gw; m < M; m += NGW) {
        f32x4 v[8];
#pragma unroll
        for (int j = 0; j < 8; ++j) v[j] = unpk4(nv[j]);
        if (m + NGW < M) { const GAS v2u* tr = (const GAS v2u*)(T + (size_t)(m + NGW) * D) + F.lane;
#pragma unroll
            for (int j = 0; j < 8; ++j) nv[j] = tr[64 * j]; }
        float mean, rstd; row_stats(v, mean, rstd);
        GAS f32x4* yo = (GAS f32x4*)(m < MP ? p.out + O_YP + (size_t)m * D : p.out + O_YS + (size_t)(m - MP) * D) + F.lane;
#pragma unroll
        for (int j = 0; j < 8; ++j) yo[64 * j] = (v[j] - mean) * rstd * g2[j] + b2[j];
    }
}
template <int NST, class Epi>
__device__ __forceinline__ void skinny_gemm(Frame& F, const bf16* A, const bf16* Bt, int N, int K, unsigned* cnt, unsigned char* ws, size_t part_off, const Epi& E) {
    constexpr int KC = 512, PITCH = KC * 2 + 16, WPS = NWAVES / NST, KSW = 16 / WPS, NC = 16 * NST;
    LAS unsigned char* As = F.lds;
    LAS float* red = (LAS float*)(F.lds + 67584);
    LAS unsigned* flag = (LAS unsigned*)(F.lds + 67584 + 32768);
    const int nks = K / KC, nns = N / NC, r16 = F.lane & 15, kq = F.lane >> 4;
    const __amdgpu_buffer_rsrc_t rw = __builtin_amdgcn_make_buffer_rsrc((void*)ws, (short)0, 0x7fffffff, 0x00020000);
    for (int u = F.bid; u < nks * nns; u += F.G) {
        const int ns = u % nns, ks = u / nns;
        { const int row = F.wave * 8 + (F.lane >> 3), seg = F.lane & 7; const bf16* src = A + (size_t)row * K + ks * KC + seg * 8; v4u t[8];
#pragma unroll
          for (int i = 0; i < 8; ++i) t[i] = *(const GAS v4u*)(src + i * 64);
#pragma unroll
          for (int i = 0; i < 8; ++i) *(LAS v4u*)(As + row * PITCH + (i * 8 + seg) * 16) = t[i]; }
        const int strip = F.wave % NST, kpart = F.wave / NST;
        const bf16* bp = Bt + (size_t)(ns * NC + strip * 16 + r16) * K + ks * KC + kpart * KSW * 32 + 8 * kq;
        bf16x8 bq[KSW];
#pragma unroll
        for (int j = 0; j < KSW; ++j) bq[j] = *(const bf16x8*)(bp + 32 * j);
        __syncthreads();
        f32x4 acc[4];
#pragma unroll
        for (int rb = 0; rb < 4; ++rb) acc[rb] = (f32x4){0.f, 0.f, 0.f, 0.f};
#pragma unroll
        for (int j = 0; j < KSW; ++j)
#pragma unroll
            for (int rb = 0; rb < 4; ++rb) { const bf16x8 a = *(const LAS bf16x8*)(As + (rb * 16 + r16) * PITCH + ((kpart * KSW + j) * 32 + 8 * kq) * 2);
                acc[rb] = __builtin_amdgcn_mfma_f32_16x16x32_bf16(a, bq[j], acc[rb], 0, 0, 0); }
#pragma unroll
        for (int rb = 0; rb < 4; ++rb)
#pragma unroll
            for (int i = 0; i < 4; ++i) red[(F.wave * 64 + rb * 16 + 4 * kq + i) * 16 + r16] = acc[rb][i];
        __syncthreads();
        for (int e = F.tid; e < 64 * NC / 4; e += NWAVES * 64) { const int row = e / (NC / 4), c4 = (e % (NC / 4)) * 4, st = c4 >> 4; f32x4 v = {0.f, 0.f, 0.f, 0.f};
#pragma unroll
            for (int w = 0; w < WPS; ++w) v += *(const LAS f32x4*)(red + ((w * NST + st) * 64 + row) * 16 + (c4 & 15));
            __builtin_amdgcn_raw_buffer_store_b128(__builtin_bit_cast(v4u, v), rw, (int)(part_off + (((size_t)ks * 64 + row) * N + ns * NC + c4) * 4), 0, 16  ); }
        VM_WAIT(); __syncthreads();
        if (F.tid == 0) { const unsigned old = xb_add(cnt + 16 * ns, 1u); const unsigned last = (old == (unsigned)(nks - 1)) ? 1u : 0u;
            if (last) { __builtin_amdgcn_fence(__ATOMIC_ACQUIRE, "agent"); VM_WAIT(); } flag[0] = last; }
        __syncthreads();
        if (flag[0]) {
            const float* p0 = (const float*)(ws + part_off) + ns * NC;
            for (int e = F.tid; e < 64 * NC / 4; e += NWAVES * 64) { const int row = e / (NC / 4), c4 = (e % (NC / 4)) * 4; f32x4 v = {0.f, 0.f, 0.f, 0.f};
                for (int k2 = 0; k2 < nks; ++k2) v += *(const f32x4*)(p0 + ((size_t)k2 * 64 + row) * N + c4);
#pragma unroll
                for (int i = 0; i < 4; ++i) E(row, ns * NC + c4 + i, v[i]); } }
        __syncthreads();
    }
}
struct SEpi1 { const P* p;
    __device__ __forceinline__ void operator()(int row, int n, float v) const { const P& q = *p; const int region = n >> 10, c = n & 1023; const size_t o = (size_t)(MP + row) * 1024 + c; const bf16 h = (bf16)f2bf(v);
        if (region == 0) { ((bf16*)(q.ws + WS_QB))[o] = h; }
        else if (region == 1) { ((bf16*)(q.ws + WS_KB))[o] = h; q.out[O_KS + (size_t)row * 1024 + c] = v; }
        else if (region == 2) { ((bf16*)(q.ws + WS_VB))[o] = h; q.out[O_VS + (size_t)row * 1024 + c] = v; }
        else { ((bf16*)(q.ws + WS_UB))[o] = h; } } };
template <bool BASE_F32> struct SEpiRes { const P* p; const void* base; int gi;
    __device__ __forceinline__ void operator()(int row, int n, float v) const { const P& q = *p;
        const float bs = BASE_F32 ? ((const float*)base)[(size_t)row * D + n] : __builtin_bit_cast(float, (unsigned)((const bf16*)base)[(size_t)row * D + n] << 16);
        ((bf16*)(q.ws + WS_T))[(size_t)(MP + row) * D + n] = (bf16)f2bf(ALPHA * bs + (1.f + modp(q, NB + row / DS, gi)[n]) * v); } };
struct SEpiRelu2 { const P* p;
    __device__ __forceinline__ void operator()(int row, int n, float v) const { const float r = fmaxf(v, 0.f); ((bf16*)(p->ws + WS_AB))[(size_t)(MP + row) * DFF + n] = (bf16)f2bf(r * r); } };

namespace att {
constexpr int D = 128, RS = 1024  , OS = 2048  ; constexpr float THR = 8.f; constexpr bool WSKIP = false;
constexpr float SCALE = 0.08838834764831845f, RSCALE = 11.313708498984761f;
constexpr int NW = 8, QBLK = 32, KVBLK = 64, QB = NW * QBLK;
constexpr int SHM_V = KVBLK * D * 2, SHM_K = KVBLK * D * 2;
constexpr int LDS_FJ = 2 * SHM_V + 2 * SHM_K + NW * 64 * 4;
constexpr int LDS_BYTES = LDS_FJ + 2 * 256;

using bf16 = unsigned short;
typedef short bf16x8 __attribute__((ext_vector_type(8)));
typedef short s16x4 __attribute__((ext_vector_type(4)));
typedef float f32x16 __attribute__((ext_vector_type(16)));
typedef float f32x4 __attribute__((ext_vector_type(4)));
typedef unsigned u32x4 __attribute__((ext_vector_type(4)));
template <class A, class Bt> struct same_t { static constexpr bool v = false; };
template <class A> struct same_t<A, A> { static constexpr bool v = true; };

#define KSWZ(row, colB) ((row) * 256 + ((colB) ^ (((row) & 7) << 4)))
#define SBAR() __builtin_amdgcn_sched_barrier(0)
__device__ __forceinline__ int v_st(int k, int c) { const int kk = (k & ~0xC) | ((k & 4) << 1) | ((k & 8) >> 1); return ((kk >> 3) * 4 + (c >> 5)) * 512 + ((kk & 7) * 32 + (c & 31)) * 2; }
__device__ __forceinline__ int v_rd_base(int lane) { return ((lane & 3) << 3) | (((lane >> 2) & 3) << 6) | (((lane >> 4) & 1) << 5) | (((lane >> 5) & 1) << 8); }
constexpr int v_rd_off(int d0, int ks, int half) { return d0 * 512 + ks * 4096 + half * 2048; }
__device__ __forceinline__ int crow(int r, int hi) { return (r & 3) + 8 * (r >> 2) + 4 * hi; }
__device__ __forceinline__ unsigned cvtpk(float lo, float hi) {
    unsigned r; asm volatile("v_cvt_pk_bf16_f32 %0, %1, %2" : "=v"(r) : "v"(lo), "v"(hi)); return r;
}
__device__ __forceinline__ bf16x8 pack8(f32x4 a, f32x4 b) {
    u32x4 w = {cvtpk(a[0], a[1]), cvtpk(a[2], a[3]), cvtpk(b[0], b[1]), cvtpk(b[2], b[3])};
    return *reinterpret_cast<bf16x8*>(&w);
}
template <class T> __device__ __forceinline__ bf16x8 load8(const T* p) {
    if constexpr (same_t<T, float>::v) { return pack8(*(const f32x4*)p, *(const f32x4*)(p + 4)); }
    else { return *reinterpret_cast<const bf16x8*>(p); }
}
__device__ __forceinline__ void mask_tile(f32x16& p0, f32x16& p1, int dq, unsigned W) {
    const float NEG = -__builtin_inff();
#pragma unroll
    for (int r = 0; r < 16; ++r) {
        const int c = (r & 3) + 8 * (r >> 2);
        if ((unsigned)(dq - c) >= W) p0[r] = NEG;
        if ((unsigned)(dq - c - 32) >= W) p1[r] = NEG;
    }
}
__device__ __forceinline__ void partialSM(f32x16& p0, f32x16& p1, float& m_reg, float& mn, float& alpha) {
    float pmax = p0[0]; for (int r = 1; r < 16; ++r) pmax = fmaxf(pmax, p0[r]); for (int r = 0; r < 16; ++r) pmax = fmaxf(pmax, p1[r]);
    { auto rr = __builtin_amdgcn_permlane32_swap(__float_as_uint(pmax), __float_as_uint(pmax), false, false);
      pmax = fmaxf(__uint_as_float(rr[0]), __uint_as_float(rr[1])); }
    constexpr float C2 = 1.4426950408889634f * SCALE;
    if (__builtin_expect(__all((pmax - m_reg) * SCALE <= THR), 1)) { mn = m_reg; alpha = 1.f; }
    else { mn = fmaxf(m_reg, pmax); alpha = __builtin_amdgcn_exp2f((m_reg - mn) * C2); m_reg = mn; }
    const float mnL = -mn * C2;
    for (int r = 0; r < 16; ++r) p0[r] = fmaf(p0[r], C2, mnL); for (int r = 0; r < 16; ++r) p1[r] = fmaf(p1[r], C2, mnL);
    for (int r = 0; r < 16; ++r) p0[r] = __builtin_amdgcn_exp2f(p0[r]);
}
__device__ __forceinline__ void finishSM(f32x16& p0, f32x16& p1, float alpha, float& l_reg, bf16x8& pa0, bf16x8& pa1, bf16x8& pa2, bf16x8& pa3) {
    for (int r = 0; r < 16; ++r) p1[r] = __builtin_amdgcn_exp2f(p1[r]);
    float ps = 0; for (int r = 0; r < 16; ++r) ps += p0[r]; for (int r = 0; r < 16; ++r) ps += p1[r];
    { auto rr = __builtin_amdgcn_permlane32_swap(__float_as_uint(ps), __float_as_uint(ps), false, false);
      ps = __uint_as_float(rr[0]) + __uint_as_float(rr[1]); }
    l_reg = l_reg * alpha + ps;
#define PK4(P, B_, OUT) do { unsigned a0 = cvtpk(P[B_+0], P[B_+1]), a1 = cvtpk(P[B_+2], P[B_+3]);                          \
        unsigned b0 = cvtpk(P[B_+4], P[B_+5]), b1 = cvtpk(P[B_+6], P[B_+7]);                                             \
        auto r0 = __builtin_amdgcn_permlane32_swap(a0, b0, false, false); auto r1 = __builtin_amdgcn_permlane32_swap(a1, b1, false, false); \
        u32x4 w = {r0[0], r1[0], r0[1], r1[1]}; OUT = *reinterpret_cast<bf16x8*>(&w); } while (0)
    PK4(p0, 0, pa0); PK4(p0, 8, pa1); PK4(p1, 0, pa2); PK4(p1, 8, pa3);
#undef PK4
}
template <int KB, bool SK>
__device__ __forceinline__ void qkt(f32x16& p0, f32x16& p1, const char* K_lds, int r32, int hi, const bf16x8* qr, bool act, float fi) {
    if (SK && !act) { const float NEG = -__builtin_inff();
#pragma unroll
        for (int r = 0; r < 16; ++r) { p0[r] = NEG; p1[r] = NEG; } return; }
    { const char* fjp = K_lds + 2 * SHM_K + NW * 64 * 4 + KB * 256 + hi * 16;
#pragma unroll
      for (int g = 0; g < 4; ++g) { const f32x4 a = *reinterpret_cast<const f32x4*>(fjp + 32 * g), b = *reinterpret_cast<const f32x4*>(fjp + 128 + 32 * g);
#pragma unroll
        for (int e = 0; e < 4; ++e) { p0[4 * g + e] = fi - a[e]; p1[4 * g + e] = fi - b[e]; } } }
    const char* kb[4];
#pragma unroll
    for (int dd = 0; dd < 4; ++dd) kb[dd] = K_lds + KB * SHM_K + KSWZ(r32, (dd * 16 + hi * 8) * 2);
#pragma unroll
    for (int d0 = 0; d0 < 8; ++d0) { const char* a = kb[d0 & 3] + (d0 >> 2) * 128;
        bf16x8 b0 = *reinterpret_cast<const bf16x8*>(a);
        bf16x8 b1 = *reinterpret_cast<const bf16x8*>(a + 32 * 256);
        p0 = __builtin_amdgcn_mfma_f32_32x32x16_bf16(b0, qr[d0], p0, 0, 0, 0);
        p1 = __builtin_amdgcn_mfma_f32_32x32x16_bf16(b1, qr[d0], p1, 0, 0, 0); }
}
template <int VB, bool SK>
__device__ __forceinline__ void pv_tile(f32x16* o, int vb0, bf16x8 pa0, bf16x8 pa1, bf16x8 pa2, bf16x8 pa3, bool act) {
    if (SK && !act) return;
#define TRRD(dst, off) asm volatile("ds_read_b64_tr_b16 %0, %1 offset:%2" : "=&v"(dst) : "v"(vb0), "i"(off) : "memory")
#define PV_D0(d0) do { s16x4 l0, l1, l2, l3, h0, h1, h2, h3; constexpr int b_ = VB * SHM_V + v_rd_off(d0, 0, 0);     \
        TRRD(l0, b_); TRRD(h0, b_ + 2048); TRRD(l1, b_ + 4096); TRRD(h1, b_ + 6144); TRRD(l2, b_ + 8192); TRRD(h2, b_ + 10240); TRRD(l3, b_ + 12288); TRRD(h3, b_ + 14336); \
        asm volatile("s_waitcnt lgkmcnt(0)" ::: "memory"); SBAR();                 \
        o[d0] = __builtin_amdgcn_mfma_f32_32x32x16_bf16(pa0, (bf16x8){l0[0], l0[1], l0[2], l0[3], h0[0], h0[1], h0[2], h0[3]}, o[d0], 0, 0, 0);   \
        o[d0] = __builtin_amdgcn_mfma_f32_32x32x16_bf16(pa1, (bf16x8){l1[0], l1[1], l1[2], l1[3], h1[0], h1[1], h1[2], h1[3]}, o[d0], 0, 0, 0);   \
        o[d0] = __builtin_amdgcn_mfma_f32_32x32x16_bf16(pa2, (bf16x8){l2[0], l2[1], l2[2], l2[3], h2[0], h2[1], h2[2], h2[3]}, o[d0], 0, 0, 0);   \
        o[d0] = __builtin_amdgcn_mfma_f32_32x32x16_bf16(pa3, (bf16x8){l3[0], l3[1], l3[2], l3[3], h3[0], h3[1], h3[2], h3[3]}, o[d0], 0, 0, 0); } while (0)
    PV_D0(0); PV_D0(1); PV_D0(2); PV_D0(3);
#undef PV_D0
#undef TRRD
}

template <class TIn, class TOut> struct BlockRef { unsigned Q, K, V, O, F; int P0; };
#define BL128(vo, so) __builtin_bit_cast(bf16x8, __builtin_amdgcn_raw_buffer_load_b128(rs, (int)(vo), (int)(so), 0))
#define BL32F(vo, so) __builtin_bit_cast(float, __builtin_amdgcn_raw_buffer_load_b32(rs, (int)(vo), (int)(so), 0))
template <class TIn> struct Seam {
    bf16x8 qr[8];
    bf16x8 st_v0, st_v1, st_k0, st_k1; float st_f;
};
__device__ __forceinline__ int swa_jlo(int P0, int W) { const int lowk = P0 - W + 1; return lowk > 0 ? lowk / KVBLK : 0; }
#define VMW() asm volatile("s_waitcnt vmcnt(0)" ::: "memory")
#define VMWN(n) asm volatile("s_waitcnt vmcnt(%0)" :: "i"(n) : "memory")
#define SLOAD_H(Kp, Vp, Fp, k0) do { const unsigned so_ = (unsigned)(k0) * (RS * 2); S.st_v0 = BL128(lkv, (Vp) + so_); S.st_v1 = BL128(lkv, (Vp) + so_ + 32 * RS * 2); \
                         S.st_k0 = BL128(lkv, (Kp) + so_); S.st_k1 = BL128(lkv, (Kp) + so_ + 32 * RS * 2); S.st_f = BL32F((tid & 63) * 4, (Fp) + (unsigned)(k0) * 4); } while (0)
#define SWRITE_HK(bf) do { *(bf16x8*)(K_lds + (bf) * SHM_K + kws) = S.st_k0; *(bf16x8*)(K_lds + (bf) * SHM_K + kws + 32 * 256) = S.st_k1; \
                           if (tid < 64) *(float*)(K_lds + 2 * SHM_K + NW * 64 * 4 + (bf) * 256 + tid * 4) = S.st_f * RSCALE; } while (0)
#define SWRITE_HV(bf) do { *(bf16x8*)(V_lds + (bf) * SHM_V + vst0) = S.st_v0; *(bf16x8*)(V_lds + (bf) * SHM_V + vst1) = S.st_v1; } while (0)
#define SWRITE_H(bf) do { SWRITE_HV(bf); SWRITE_HK(bf); } while (0)
template <class TIn, class TOut>
__device__ __forceinline__ void causal_swa_prime(const BlockRef<TIn, TOut>& cur, int W, char* lds, Seam<TIn>& S, __amdgpu_buffer_rsrc_t rs, const int tid_in) {
    constexpr bool F32 = same_t<TIn, float>::v;
    const int tid = tid_in, wid = __builtin_amdgcn_readfirstlane(tid >> 6), lane = tid & 63, r32 = lane & 31, hi = lane >> 5;
    const int sr = tid >> 4, sc = (tid & 15) * 8, kws = KSWZ(sr, sc * 2); char* K_lds = lds + 2 * SHM_V;
    const int lkv = (sr * RS + sc) * 2, lq = ((wid * QBLK + r32) * RS + hi * 8) * 2;
    const int kb0 = swa_jlo(cur.P0, W) * KVBLK;
#pragma unroll
    for (int d0 = 0; d0 < 8; ++d0) S.qr[d0] = BL128(lq + d0 * 32, cur.Q);
    SLOAD_H(cur.K, cur.V, cur.F, kb0); VMW(); SWRITE_HK(0);
    __syncthreads();
}
template <class TIn, class TOut>
__device__ __forceinline__ void causal_swa_block(const BlockRef<TIn, TOut>& cur, const BlockRef<TIn, TOut>& nxt, int skv, int W, char* lds, Seam<TIn>& S, __amdgpu_buffer_rsrc_t rs, const int tid_in) {
    constexpr bool F32 = same_t<TIn, float>::v;
    const int tid = tid_in, wid = __builtin_amdgcn_readfirstlane(tid >> 6), lane = tid & 63, r32 = lane & 31, hi = lane >> 5;
    const int j_lo = swa_jlo(cur.P0, W);
    int j_hi = (cur.P0 + QB - 1) / KVBLK + 1; if (j_hi > skv / KVBLK) j_hi = skv / KVBLK;
    const int NT = j_hi - j_lo;
    const int kbn = swa_jlo(nxt.P0, W) * KVBLK;
    const int qlo = cur.P0 + wid * QBLK, qm = qlo + r32 - 4 * hi;
    char* V_lds = lds; char* K_lds = lds + 2 * SHM_V;
    float* ws = (float*)(lds + 2 * SHM_V + 2 * SHM_K) + wid * 64; float* li_l = ws, * al_l = ws + 32;
    float m_reg = -1e30f, l_reg = 0; f32x16 o[4] = {};
    const int sr = tid >> 4, sc = (tid & 15) * 8, vst0 = v_st(sr, sc), vst1 = v_st(32 + sr, sc), kws = KSWZ(sr, sc * 2);
    const int vb0 = (int)(uintptr_t)V_lds + v_rd_base(lane);
    const unsigned Kh = cur.K, Vh = cur.V, Fh = cur.F;
    const int lkv = (sr * RS + sc) * 2, lq = ((wid * QBLK + r32) * RS + hi * 8) * 2;
    const float fi = BL32F((wid * QBLK + r32) * 4, cur.F + (unsigned)cur.P0 * 4) * RSCALE;
#define RESC(a) do { if (__any((a) < 1.f)) { if (hi == 0) al_l[r32] = (a); asm volatile("s_waitcnt lgkmcnt(0)" ::: "memory");              \
                     for (int d_ = 0; d_ < 4; ++d_) for (int r = 0; r < 16; ++r) o[d_][r] *= al_l[crow(r, hi)]; } } while (0)
#define KBASE(t) ((j_lo + (t)) * KVBLK)
#define ACT(t) (KBASE(t) <= qlo + QBLK - 1 && KBASE(t) + KVBLK - 1 >= qlo - W + 1)
#define MASKT(P0_, P1_, t) do { const int kb_ = KBASE(t); if ((!SK || ACT(t)) && (kb_ + KVBLK - 1 > qlo || kb_ <= qlo + QBLK - 1 - W)) mask_tile(P0_, P1_, qm - kb_, (unsigned)W); } while (0)
    constexpr int NQL = F32 ? 16 : 8;
    constexpr bool SK = WSKIP && !F32;
#define SEAM_K0() do { VMWN(NQL); SWRITE_HK(0); SBAR(); } while (0)
    f32x16 pA0, pA1, pB0, pB1; float mnA, mnB, alA, alB; bf16x8 pa0, pa1, pa2, pa3;
    SWRITE_HV(0); SBAR();
    if (NT > 1) { SLOAD_H(Kh, Vh, Fh, KBASE(1)); }
    SBAR(); qkt<0, SK>(pA0, pA1, K_lds, r32, hi, S.qr, ACT(0), fi);
    MASKT(pA0, pA1, 0); partialSM(pA0, pA1, m_reg, mnA, alA);
    if (NT > 1) { VMW(); SWRITE_H(1); }
    __syncthreads();
#define HALF_STEP(PX0, PX1, mnX, alX, PY0, PY1, alY, t, KB, VB, SB) do {                                                      \
        SBAR(); qkt<KB, SK>(PX0, PX1, K_lds, r32, hi, S.qr, ACT(t), fi);                                         \
        finishSM(PY0, PY1, alY, l_reg, pa0, pa1, pa2, pa3); SBAR();                                                           \
        if ((t) + 1 < NT) { SLOAD_H(Kh, Vh, Fh, KBASE((t) + 1)); SBAR(); }                                                   \
        pv_tile<VB, SK>(o, vb0, pa0, pa1, pa2, pa3, ACT((t) - 1)); MASKT(PX0, PX1, (t)); partialSM(PX0, PX1, m_reg, mnX, alX);                                        \
        __syncthreads();                                                                                                      \
        if ((t) + 1 < NT) { VMW(); SWRITE_H(SB); }                                                                            \
        RESC(alX); __syncthreads(); } while (0)
    for (int t = 1; t + 1 < NT; t += 2) {
        HALF_STEP(pB0, pB1, mnB, alB, pA0, pA1, alA, t, 1, 0, 0);
        HALF_STEP(pA0, pA1, mnA, alA, pB0, pB1, alB, t + 1, 0, 1, 1);
    }
    const bool even = (NT & 1) == 0;
    if (even) { SBAR(); qkt<1, SK>(pB0, pB1, K_lds, r32, hi, S.qr, ACT(NT - 1), fi); SBAR(); }
    { SLOAD_H(nxt.K, nxt.V, nxt.F, kbn); SBAR();
#pragma unroll
        for (int d0 = 0; d0 < 8; ++d0) S.qr[d0] = BL128(lq + d0 * 32, nxt.Q); }
    SBAR();
    finishSM(pA0, pA1, alA, l_reg, pa0, pa1, pa2, pa3); SBAR();
    pv_tile<0, SK>(o, vb0, pa0, pa1, pa2, pa3, ACT(even ? NT - 2 : NT - 1));
    if (even) { MASKT(pB0, pB1, NT - 1); partialSM(pB0, pB1, m_reg, mnB, alB); __syncthreads(); RESC(alB);
        finishSM(pB0, pB1, alB, l_reg, pa0, pa1, pa2, pa3); SBAR(); pv_tile<1, SK>(o, vb0, pa0, pa1, pa2, pa3, ACT(NT - 1)); }
    SBAR(); SEAM_K0();
    if (hi == 0) li_l[r32] = l_reg; asm volatile("s_waitcnt lgkmcnt(0)" ::: "memory");
    float rli[16];
#pragma unroll
    for (int r = 0; r < 16; ++r) rli[r] = __builtin_amdgcn_rcpf(li_l[crow(r, hi)]);
    const int lo_ = ((wid * QBLK + 4 * hi) * OS + r32) * 2;
#pragma unroll
    for (int r = 0; r < 16; ++r) { const unsigned so_ = cur.O + (unsigned)(((r & 3) + 8 * (r >> 2)) * OS * 2);
#pragma unroll
        for (int d0 = 0; d0 < 4; ++d0) { const float v = o[d0][r] * rli[r];
            { const float vn = __builtin_bit_cast(float, __builtin_amdgcn_mov_dpp(__builtin_bit_cast(int, v), 0xB1, 0xf, 0xf, true));
                   if ((r32 & 1) == 0) __builtin_amdgcn_raw_buffer_store_b32(cvtpk(v, vn), rs, lo_ + d0 * 64, (int)so_, 0); } } }
    __syncthreads();
#undef RESC
#undef KBASE
#undef ACT
#undef MASKT
#undef SEAM_K0
#undef HALF_STEP
}
#undef ROW
#undef VMW
#undef VMWN
#undef SLOAD_H
#undef SWRITE_HK
#undef SWRITE_HV
#undef SWRITE_H

}


namespace dec {
using bf16x2 = __attribute__((ext_vector_type(2))) __bf16;
using u32x4  = __attribute__((ext_vector_type(4))) unsigned;
using f32x4  = __attribute__((ext_vector_type(4))) float;
using f32x8  = __attribute__((ext_vector_type(8))) float;
constexpr int GE = 8, GEP = 8, HPL = 2, SPL = (256 - 144) / DB, NGRP = PAST / 16;
constexpr float LOG2E = 1.4426950408889634f, C2 = SCALE * LOG2E;
typedef short s16x4_t __attribute__((ext_vector_type(4)));
typedef unsigned u32x2 __attribute__((ext_vector_type(2)));
__device__ __forceinline__ float dot2(unsigned k, unsigned q, float acc) { return __builtin_amdgcn_fdot2_f32_bf16(__builtin_bit_cast(bf16x2, k), __builtin_bit_cast(bf16x2, q), acc, false); }
__device__ __forceinline__ unsigned cvtpk(float lo, float hi) { unsigned r; asm volatile("v_cvt_pk_bf16_f32 %0, %1, %2" : "=v"(r) : "v"(lo), "v"(hi)); return r; }
template <int CTRL> __device__ __forceinline__ float dpp(float x) { return __builtin_bit_cast(float, __builtin_amdgcn_mov_dpp(__builtin_bit_cast(int, x), CTRL, 0xf, 0xf, true)); }
constexpr int XOR1 = 0xB1, XOR2 = 0x4E, XOR7 = 0x141, XOR8 = 0x128, ROR4 = 0x124;
__device__ __forceinline__ float xrow16_max(float x) {
  auto s = __builtin_amdgcn_permlane16_swap(__float_as_uint(x), __float_as_uint(x), false, false); x = fmaxf(__uint_as_float(s[0]), __uint_as_float(s[1]));
  auto t = __builtin_amdgcn_permlane32_swap(__float_as_uint(x), __float_as_uint(x), false, false); return fmaxf(__uint_as_float(t[0]), __uint_as_float(t[1])); }
__device__ __forceinline__ float xrow16_sum(float x) {
  auto s = __builtin_amdgcn_permlane16_swap(__float_as_uint(x), __float_as_uint(x), false, false); x = __uint_as_float(s[0]) + __uint_as_float(s[1]);
  auto t = __builtin_amdgcn_permlane32_swap(__float_as_uint(x), __float_as_uint(x), false, false); return __uint_as_float(t[0]) + __uint_as_float(t[1]); }
__device__ __forceinline__ u32x4 tobf2(u32x4 a, u32x4 b) { u32x4 w = {cvtpk(__uint_as_float(a[0]), __uint_as_float(a[1])), cvtpk(__uint_as_float(a[2]), __uint_as_float(a[3])), cvtpk(__uint_as_float(b[0]), __uint_as_float(b[1])), cvtpk(__uint_as_float(b[2]), __uint_as_float(b[3]))}; return w; }

__device__ __forceinline__ void split_wave(const P& p, int b, int s, int h, int lane, float* pex  , LAS unsigned char* slot  ) {
  const int r = lane >> 4, c = lane & 15;
  const unsigned short* Qb = (const unsigned short*)(p.ws + WS_QB);
  u32x4* qlds = reinterpret_cast<u32x4*>(pex + 256);
  if (r == 0) {
#pragma unroll
    for (int g = 0; g < GEP; ++g) { const unsigned short* qp = Qb + (size_t)(MP + b * DS + g) * AW + h * HD + 4 * c;
      const u32x2 q0 = *reinterpret_cast<const u32x2*>(qp), q1 = *reinterpret_cast<const u32x2*>(qp + 64); qlds[g * 16 + c] = (u32x4){q0.x, q0.y, q1.x, q1.y}; }
  }
  asm volatile("s_waitcnt vmcnt(0) lgkmcnt(0)" ::: "memory");
  const int gbeg = (s * NGRP) / SPL, gend = ((s + 1) * NGRP) / SPL, pg0 = gbeg >> 3;
  int btv = 0; if (lane < 16) { const int pgi = pg0 + lane; btv = p.pt[b * NPG + (pgi < NPG ? pgi : NPG - 1)]; }
  const __amdgpu_buffer_rsrc_t rk = __builtin_amdgcn_make_buffer_rsrc((void*)p.ck, (short)0, 0x7fffffff, 0x00020000), rv = __builtin_amdgcn_make_buffer_rsrc((void*)p.cv, (short)0, 0x7fffffff, 0x00020000);
  const __amdgpu_buffer_rsrc_t rw = __builtin_amdgcn_make_buffer_rsrc((void*)p.ws, (short)0, 0x7fffffff, 0x00020000);
  const int lo4 = (r * AW + h * HD + 4 * c) * 4;
  const int ld4 = (r + 4 * (c >> 2)) * 4; const int dbase = (int)WS_DEC + ((b * NH + h) * PAST) * 4;
#define GOFF(i_) const int phys_ = __builtin_amdgcn_readlane(btv, ((i_) >> 3) - pg0); const int so_ = phys_ * (PAGE * AW * 4) + ((i_) & 7) * (16 * AW * 4)
#define DISSUE(i_) do { GOFF(i_); \
    dn = __builtin_bit_cast(float, __builtin_amdgcn_raw_buffer_load_b32(rw, ld4, dbase + (i_) * 64, 0)); \
    _Pragma("unroll") for (int t_ = 0; t_ < 4; ++t_) { Kn[t_][0] = __builtin_amdgcn_raw_buffer_load_b128(rk, lo4, so_ + t_ * (4 * AW * 4), 2); Kn[t_][1] = __builtin_amdgcn_raw_buffer_load_b128(rk, lo4 + 256, so_ + t_ * (4 * AW * 4), 2); \
                                                      Vn[t_][0] = __builtin_amdgcn_raw_buffer_load_b128(rv, lo4, so_ + t_ * (4 * AW * 4), 2); Vn[t_][1] = __builtin_amdgcn_raw_buffer_load_b128(rv, lo4 + 256, so_ + t_ * (4 * AW * 4), 2); } } while (0)
#define DMAISSUE(i_) do { GOFF(i_); \
    dn2 = __builtin_bit_cast(float, __builtin_amdgcn_raw_buffer_load_b32(rw, ld4, dbase + (i_) * 64, 0)); \
    _Pragma("unroll") for (int t_ = 0; t_ < 4; ++t_) _Pragma("unroll") for (int hf_ = 0; hf_ < 2; ++hf_) { \
        __builtin_amdgcn_raw_ptr_buffer_load_lds(rk, (LAS void*)(slot + (t_ * 2 + hf_) * 1024), 16, lo4 + 256 * hf_, so_ + t_ * (4 * AW * 4), 0, 2); \
        __builtin_amdgcn_raw_ptr_buffer_load_lds(rv, (LAS void*)(slot + 8192 + (t_ * 2 + hf_) * 1024), 16, lo4 + 256 * hf_, so_ + t_ * (4 * AW * 4), 0, 2); } } while (0)
  u32x4 Kn[4][2], Vn[4][2]; float dn, dn2 = 0.f;
  float m[HPL], l[HPL]; f32x4 accm[8];
#pragma unroll
  for (int j = 0; j < HPL; ++j) { m[j] = -INFINITY; l[j] = 0.f; }
#pragma unroll
  for (int k = 0; k < 8; ++k) accm[k] = (f32x4){0.f, 0.f, 0.f, 0.f};
  auto math = [&](const u32x4 (&Kc)[4], const u32x2 (&Vb)[8], const float dcur) {
    float x[4 * GEP];
#pragma unroll
    for (int g = 0; g < GEP; ++g) { const u32x4 qg = qlds[g * 16 + c];
#pragma unroll
      for (int t = 0; t < 4; ++t) { float d = 0.f;
#pragma unroll
        for (int k = 0; k < 4; ++k) d = dot2(Kc[t][k], qg[k], d);
        x[t * GEP + g] = d; } }
#define TR_STEP(HALF, CTRL, BIT) _Pragma("unroll") for (int hh = 0; hh < (HALF); ++hh) _Pragma("unroll") for (int j = 0; j < HPL; ++j) { \
      const float lo_ = x[hh * HPL + j], hi_ = x[(hh + (HALF)) * HPL + j]; const float t1_ = lo_ + dpp<CTRL>(lo_), t2_ = hi_ + dpp<CTRL>(hi_); \
      x[hh * HPL + j] = (c & (BIT)) ? t2_ : t1_; }
    TR_STEP(8, XOR8, 8) TR_STEP(4, XOR7, 4) TR_STEP(2, XOR2, 2) TR_STEP(1, XOR1, 1)
#undef TR_STEP
    float pj[HPL], alpha[HPL];
#pragma unroll
    for (int j = 0; j < HPL; ++j) {
      const float sc = fmaf(x[j], C2, dcur);
      float pm = sc; pm = fmaxf(pm, dpp<ROR4>(pm)); pm = fmaxf(pm, dpp<XOR8>(pm)); pm = xrow16_max(pm);
      const float mn = fmaxf(m[j], pm), msub = (mn == -INFINITY) ? 0.f : mn;
      alpha[j] = __builtin_amdgcn_exp2f(m[j] - msub); pj[j] = __builtin_amdgcn_exp2f(sc - msub);
      l[j] = fmaf(l[j], alpha[j], pj[j]); m[j] = mn;
    }
#pragma unroll
    for (int j = 0; j < HPL; ++j) pex[(r * 8 + 2 * (c & 3) + j) * 4 + (c >> 2)] = pj[j];
    if (lane < 4) { pex[128 + 2 * lane] = alpha[0]; pex[128 + 2 * lane + 1] = alpha[1]; }
    asm volatile("s_waitcnt lgkmcnt(0)" ::: "memory");
    const f32x4 pa = *reinterpret_cast<const f32x4*>(pex + (r * 8 + (c & 7)) * 4);
    const f32x4 av = *reinterpret_cast<const f32x4*>(pex + 128 + 4 * (r & 1));
    asm volatile("s_waitcnt lgkmcnt(0)" ::: "memory");
    u32x2 pa16; pa16.x = cvtpk(pa[0], pa[1]); pa16.y = cvtpk(pa[2], pa[3]);
    if (c >= 8) { pa16.x = 0u; pa16.y = 0u; }
#pragma unroll
    for (int e = 0; e < 8; ++e) { accm[e] = accm[e] * av;
      accm[e] = __builtin_amdgcn_mfma_f32_16x16x16bf16_1k(__builtin_bit_cast(s16x4_t, pa16), __builtin_bit_cast(s16x4_t, Vb[e]), accm[e], 0, 0, 0); }
  };
  DISSUE(gbeg);
  if (gbeg + 1 < gend) DMAISSUE(gbeg + 1);
  for (int i = gbeg; i < gend; i += 2) {
    { u32x4 Kc[4]; u32x2 Vb[8];
#pragma unroll
      for (int t = 0; t < 4; ++t) Kc[t] = tobf2(Kn[t][0], Kn[t][1]);
#pragma unroll
      for (int e = 0; e < 8; ++e) { Vb[e].x = cvtpk(__uint_as_float(Vn[0][e >> 2][e & 3]), __uint_as_float(Vn[1][e >> 2][e & 3])); Vb[e].y = cvtpk(__uint_as_float(Vn[2][e >> 2][e & 3]), __uint_as_float(Vn[3][e >> 2][e & 3])); }
      const float dcur = dn * LOG2E;
      if (i + 2 < gend) DISSUE(i + 2);
      math(Kc, Vb, dcur); }
    if (i + 1 < gend) { u32x4 Kc[4]; u32x2 Vb[8];
      const float dcur = dn2 * LOG2E;
      if (i + 2 < gend) asm volatile("s_waitcnt vmcnt(17)" ::: "memory"); else asm volatile("s_waitcnt vmcnt(0)" ::: "memory");
      u32x4 Vr[4][2];
#pragma unroll
      for (int t = 0; t < 4; ++t) { const LAS u32x4* kp = (const LAS u32x4*)(slot + (t * 2) * 1024) + lane; const LAS u32x4* vp = (const LAS u32x4*)(slot + 8192 + (t * 2) * 1024) + lane;
        Kc[t] = tobf2(kp[0], kp[64]); Vr[t][0] = vp[0]; Vr[t][1] = vp[64]; }
#pragma unroll
      for (int e = 0; e < 8; ++e) { Vb[e].x = cvtpk(__uint_as_float(Vr[0][e >> 2][e & 3]), __uint_as_float(Vr[1][e >> 2][e & 3])); Vb[e].y = cvtpk(__uint_as_float(Vr[2][e >> 2][e & 3]), __uint_as_float(Vr[3][e >> 2][e & 3])); }
      asm volatile("s_waitcnt lgkmcnt(0)" ::: "memory");
      if (i + 3 < gend) DMAISSUE(i + 3);
      math(Kc, Vb, dcur); }
  }
#undef DISSUE
#undef DMAISSUE
#undef GOFF
#pragma unroll
  for (int j = 0; j < HPL; ++j) { float t = l[j]; t += dpp<ROR4>(t); t += dpp<XOR8>(t); l[j] = xrow16_sum(t); }
  float* po = (float*)(p.ws + WS_PO); float* pml = (float*)(p.ws + WS_PML);
  if (r < 2) {
#pragma unroll
    for (int i = 0; i < 4; ++i) { const size_t slot_ = (size_t)(((b * NH + h) * DS + 4 * r + i) * SPL + s);
      *reinterpret_cast<f32x4*>(po + slot_ * HD + 4 * c) = f32x4{accm[0][i], accm[1][i], accm[2][i], accm[3][i]};
      *reinterpret_cast<f32x4*>(po + slot_ * HD + 64 + 4 * c) = f32x4{accm[4][i], accm[5][i], accm[6][i], accm[7][i]}; } }
  if (r == 0) {
#pragma unroll
    for (int g = 0; g < GE; ++g) { const size_t slot_ = (size_t)(((b * NH + h) * DS + g) * SPL + s);
      if (c == g / HPL) { pml[2 * slot_] = m[g % HPL]; pml[2 * slot_ + 1] = l[g % HPL]; } } }
}
__device__ __forceinline__ void combine_row(const P& p, int row, int lane) {
  const int b = row >> 6, h = (row >> 3) & 7, q = row & 7, d0 = 2 * lane;
  const unsigned short* Qb = (const unsigned short*)(p.ws + WS_QB); const unsigned short* Kb = (const unsigned short*)(p.ws + WS_KB); const unsigned short* Vb = (const unsigned short*)(p.ws + WS_VB);
  const float* LF = (const float*)(p.ws + WS_LF); const float* po = (const float*)(p.ws + WS_PO); const float* pml = (const float*)(p.ws + WS_PML);
  const unsigned qw = *reinterpret_cast<const unsigned*>(Qb + (size_t)(MP + b * DS + q) * AW + h * HD + d0);
  const float q0 = __builtin_bit_cast(float, qw << 16), q1 = __builtin_bit_cast(float, qw & 0xffff0000u);
  float s2[DS], v0[DS], v1[DS]; float fsum = 0.f;
#pragma unroll
  for (int j = 0; j < DS; ++j) {
    fsum += LF[(size_t)(MP + b * DS + j) * NH + h];
    const unsigned kw = *reinterpret_cast<const unsigned*>(Kb + (size_t)(MP + b * DS + j) * AW + h * HD + d0);
    const unsigned vw = *reinterpret_cast<const unsigned*>(Vb + (size_t)(MP + b * DS + j) * AW + h * HD + d0);
    v0[j] = __builtin_bit_cast(float, vw << 16); v1[j] = __builtin_bit_cast(float, vw & 0xffff0000u);
    const float dt = wave_sum(q0 * __builtin_bit_cast(float, kw << 16) + q1 * __builtin_bit_cast(float, kw & 0xffff0000u));
    s2[j] = (j <= q) ? dt * C2 - fsum * LOG2E : -INFINITY;
  }
  const size_t slot0 = (size_t)row * SPL;
  float Mx = -INFINITY;
#pragma unroll
  for (int s = 0; s < SPL; ++s) Mx = fmaxf(Mx, pml[2 * (slot0 + s)]);
#pragma unroll
  for (int j = 0; j < DS; ++j) Mx = fmaxf(Mx, s2[j]);
  float L = 0.f, o0 = 0.f, o1 = 0.f;
#pragma unroll
  for (int s = 0; s < SPL; ++s) { const float ls = pml[2 * (slot0 + s) + 1], w = (ls > 0.f) ? __builtin_amdgcn_exp2f(pml[2 * (slot0 + s)] - Mx) : 0.f;
    const float2 a = *reinterpret_cast<const float2*>(po + (slot0 + s) * HD + d0); L = fmaf(w, ls, L); o0 = fmaf(w, a.x, o0); o1 = fmaf(w, a.y, o1); }
#pragma unroll
  for (int j = 0; j < DS; ++j) { const float pj = __builtin_amdgcn_exp2f(s2[j] - Mx); L += pj; o0 = fmaf(pj, v0[j], o0); o1 = fmaf(pj, v1[j], o1); }
  const float inv = 1.f / L;
  *reinterpret_cast<unsigned*>((unsigned short*)(p.ws + WS_ASB) + (size_t)(MP + b * DS + q) * D + h * HD + d0) = pk2(o0 * inv, o1 * inv);
}
}
constexpr int ATT_NP = 144, ATT_MAXB = 2;
__device__ const short ATT_SCHED[ATT_NP][ATT_MAXB] = {
  {255,-1},
  {239,-1},
  {223,-1},
  {207,-1},
  {191,-1},
  {175,-1},
  {159,-1},
  {143,-1},
  {127,-1},
  {111,-1},
  {95,-1},
  {79,-1},
  {63,-1},
  {47,-1},
  {31,-1},
  {15,-1},
  {254,-1},
  {238,-1},
  {222,-1},
  {206,-1},
  {190,-1},
  {174,-1},
  {158,-1},
  {142,-1},
  {126,-1},
  {110,-1},
  {94,-1},
  {78,-1},
  {62,-1},
  {46,-1},
  {30,-1},
  {14,-1},
  {253,240},
  {237,224},
  {221,208},
  {205,192},
  {189,176},
  {173,160},
  {157,144},
  {141,128},
  {125,112},
  {109,96},
  {93,80},
  {77,64},
  {61,48},
  {45,32},
  {29,16},
  {13,0},
  {252,241},
  {236,225},
  {220,209},
  {204,193},
  {188,177},
  {172,161},
  {156,145},
  {140,129},
  {124,113},
  {108,97},
  {92,81},
  {76,65},
  {60,49},
  {44,33},
  {28,17},
  {12,1},
  {251,242},
  {235,226},
  {219,210},
  {203,194},
  {187,178},
  {171,162},
  {155,146},
  {139,130},
  {123,114},
  {107,98},
  {91,82},
  {75,66},
  {59,50},
  {43,34},
  {27,18},
  {11,2},
  {250,243},
  {234,227},
  {218,211},
  {202,195},
  {186,179},
  {170,163},
  {154,147},
  {138,131},
  {122,115},
  {106,99},
  {90,83},
  {74,67},
  {58,51},
  {42,35},
  {26,19},
  {10,3},
  {249,244},
  {233,228},
  {217,212},
  {201,196},
  {185,180},
  {169,164},
  {153,148},
  {137,132},
  {121,116},
  {105,100},
  {89,84},
  {73,68},
  {57,52},
  {41,36},
  {25,20},
  {9,4},
  {248,245},
  {232,229},
  {216,213},
  {200,197},
  {184,181},
  {168,165},
  {152,149},
  {136,133},
  {120,117},
  {104,101},
  {88,85},
  {72,69},
  {56,53},
  {40,37},
  {24,21},
  {8,5},
  {247,246},
  {231,230},
  {215,214},
  {199,198},
  {183,182},
  {167,166},
  {151,150},
  {135,134},
  {119,118},
  {103,102},
  {87,86},
  {71,70},
  {55,54},
  {39,38},
  {23,22},
  {7,6}
};
__device__ __forceinline__ void phase_attn_prompt(const P& p, char* lds, int wg, const int tid) {
    typedef att::BlockRef<att::bf16, att::bf16> BR;
    const __amdgpu_buffer_rsrc_t rs = __builtin_amdgcn_make_buffer_rsrc((void*)p.ws, (short)0, 0x7fffffff, 0x00020000);
    constexpr int NQB = SEQ / att::QB;
    constexpr int W = 1 << 30;
    auto mk = [&](int id) { const int bh = id / NQB, qb = id % NQB, b = bh / NH, h = bh % NH; const unsigned row0 = (unsigned)(b * SEQ + qb * att::QB);
        BR r; r.Q = (unsigned)WS_QB + (row0 * att::RS + h * HD) * 2u; r.O = (unsigned)WS_ASB + (row0 * att::OS + h * HD) * 2u;
        r.K = (unsigned)WS_KB + ((unsigned)(b * SEQ) * att::RS + h * HD) * 2u; r.V = (unsigned)WS_VB + ((unsigned)(b * SEQ) * att::RS + h * HD) * 2u;
        r.F = (unsigned)WS_FC + (unsigned)(bh * SEQ) * 4u; r.P0 = qb * att::QB; return r; };
    int slot = 0;
    BR cur = mk(ATT_SCHED[wg][0]);
    att::Seam<att::bf16> S;
    att::causal_swa_prime<att::bf16, att::bf16>(cur, W, lds, S, rs, tid);
    for (;;) {
        const int nid = (slot + 1 < ATT_MAXB) ? (int)ATT_SCHED[wg][slot + 1] : -1;
        const bool last = nid < 0;
        const BR nxt = last ? cur : mk(nid);
        att::causal_swa_block<att::bf16, att::bf16>(cur, nxt, SEQ, W, lds, S, rs, tid);
        if (last) break;
        cur = nxt; ++slot;
    }
}
__global__ void __launch_bounds__(NWAVES * 64, 2) mega(P p) {
#define LOADP() do { int l_; asm volatile("v_mbcnt_lo_u32_b32 %0, -1, 0\n\tv_mbcnt_hi_u32_b32 %0, -1, %0" : "=v"(l_)); F.lane = l_; F.tid = F.wave * 64 + l_; } while (0)
    extern __shared__ __attribute__((aligned(16))) unsigned char lds[];
    Frame F;
    F.lds = (LAS unsigned char*)lds; F.tid = threadIdx.x; F.lane = F.tid & 63; F.wave = __builtin_amdgcn_readfirstlane(F.tid >> 6); F.G = gridDim.x; F.bid = blockIdx.x;
    volatile LAS unsigned* MISC = (volatile LAS unsigned*)(F.lds + MISC_OFF);
    for (int u = F.tid; u < (LDS_BYTES - LDSCTL_OFF) / 4; u += NWAVES * 64) ((LAS unsigned*)(F.lds + LDSCTL_OFF))[u] = 0u;
    __syncthreads();
    XcdBarrier bar = xcd_barrier_post((unsigned*)p.ws + CW_BAR, MISC + 8, F.tid);
#ifndef PHMASK
#define PHMASK 0xFFFF
#endif
#define IN(k) ((PHMASK >> (k)) & 1)
#define BOTH(k) (IN(k) && IN((k) + 1))
    if (IN(0)) { LOADP(); p0_prologue(p, F); __syncthreads(); }
    if (IN(1)) { LOADP(); phase_l0(p, F, bar.bar); if (BOTH(1)) xcd_barrier(bar, F.tid); }
    if (IN(2)) { LOADP();
        if (F.bid < NB * NH) scan_fc(p, F, F.bid);
        { SEpi1 E{&p}; skinny_gemm<4>(F, (const bf16*)(p.ws + WS_HB) + (size_t)MP * D, (const bf16*)(p.ws + WS_W1T), N1, D, (unsigned*)p.ws + CW_SK + 0 * 1024, p.ws, WS_SPART, E); }
        pg8::Gemm g{(const bf16*)(p.ws + WS_HB), (const bf16*)(p.ws + WS_W1T), MP, N1, D}; pg8::StaticOrder S; S.init(MP, N1, F.G, F.bid);
        pg8::EpiQKVU E{(bf16*)(p.ws + WS_QB), (bf16*)(p.ws + WS_KB), (bf16*)(p.ws + WS_VB), (bf16*)(p.ws + WS_UB), p.out + O_KP, p.out + O_VP, nullptr, nullptr};
        pg8::gemm_phase<pg8::EpiQKVU, pg8::StaticOrder, true, true>(F.lds + RING_OFF, g, S, E, F.tid);
        if (BOTH(2)) xcd_barrier(bar, F.tid);
    }
    if (IN(3)) { LOADP();
        if (F.G == 256 && F.bid < ATT_NP) { ssm::Tab T; const int g = (F.bid * NWAVES + F.wave) % NG; ssm::load_tab<false>(p, g, F.lane, T);
            for (int u = F.bid * NWAVES + F.wave; u < NG * ssm::NCH; u += ATT_NP * NWAVES) ssm::unit<0>(p, T, g, u / NG, F.lane, F.lds);
            VM_WAIT(); __syncthreads();
            if (F.tid == 0) { __builtin_amdgcn_fence(__ATOMIC_RELEASE, "agent"); VM_WAIT(); (void)xb_add((unsigned*)p.ws + CW_SSMA, 1u); } }
        if (F.G == 256) {
            if (F.bid < ATT_NP) {
                phase_attn_prompt(p, (char*)lds, F.bid, F.tid);
                LOADP();
                if (F.tid == 0) { XB_SPIN(xb_ld((unsigned*)p.ws + CW_SSMA) < (unsigned)ATT_NP, bar.bar); __builtin_amdgcn_fence(__ATOMIC_ACQUIRE, "agent"); VM_WAIT(); }
                __syncthreads();
                LAS unsigned char* img = F.lds + F.wave * ssm::WIMG;
                static_assert((ATT_NP * NWAVES) % NG == 0, "a wave's S5 units must share one group");
                ssm::Tab T; const int g = (F.bid * NWAVES + F.wave) % NG; ssm::load_tab<true>(p, g, F.lane, T);
                for (int u = F.bid * NWAVES + F.wave; u < NG * ssm::NCH + NG * (DB / 2); u += ATT_NP * NWAVES) {
                    if (u < NG * ssm::NCH) ssm::unit<1>(p, T, g, u / NG, F.lane, img);
                    else ssm::unit<2>(p, T, g, (u - NG * ssm::NCH) / NG, F.lane, img); }
            } else { const int idx = F.bid - ATT_NP; dec::split_wave(p, idx / dec::SPL, idx % dec::SPL, F.wave, F.lane, (float*)(lds + DEC_PEX_OFF) + F.wave * 768, F.lds + F.wave * 16384); }
        }
        if (BOTH(3)) xcd_barrier(bar, F.tid);
    }
    if (IN(4)) { LOADP();
        for (int row = F.bid * NWAVES + F.wave; row < DB * NH * DS; row += F.G * NWAVES) dec::combine_row(p, row, F.lane);
        if (BOTH(4)) xcd_barrier(bar, F.tid);
    }
    if (IN(5)) { LOADP();
        const bf16* ASB = (const bf16*)(p.ws + WS_ASB);
        { SEpiRes<true> E{&p, p.xs, 2}; skinny_gemm<2>(F, ASB + (size_t)MP * D, (const bf16*)(p.ws + WS_W2T), D, D, (unsigned*)p.ws + CW_SK + 1 * 1024, p.ws, WS_SPART, E); }
        pg8::Gemm g{ASB, (const bf16*)(p.ws + WS_W2T), MP, D, D}; pg8::StaticOrder S; S.init(MP, D, F.G, F.bid);
        pg8::EpiRes<true> E{p.xp, modp(p, 0, 2), (bf16*)(p.ws + WS_T)};
        pg8::gemm_phase<pg8::EpiRes<true>, pg8::StaticOrder, false, true>(F.lds + RING_OFF, g, S, E, F.tid);
        if (BOTH(5)) xcd_barrier(bar, F.tid);
    }
    if (IN(6)) { LOADP(); phase_l1(p, F); if (BOTH(6)) xcd_barrier(bar, F.tid); }
    if (IN(7)) { LOADP();
        { SEpiRelu2 E{&p}; skinny_gemm<8>(F, (const bf16*)(p.ws + WS_HB) + (size_t)MP * D, (const bf16*)(p.ws + WS_W3T), DFF, D, (unsigned*)p.ws + CW_SK + 2 * 1024, p.ws, WS_SPART, E); }
        pg8::Gemm g{(const bf16*)(p.ws + WS_HB), (const bf16*)(p.ws + WS_W3T), MP, DFF, D}; pg8::StaticOrder S; S.init(MP, DFF, F.G, F.bid);
        pg8::EpiRelu2 E{(bf16*)(p.ws + WS_AB), DFF};
        pg8::gemm_phase<pg8::EpiRelu2, pg8::StaticOrder, true, true>(F.lds + RING_OFF, g, S, E, F.tid);
        if (BOTH(7)) xcd_barrier(bar, F.tid);
    }
    if (IN(8)) { LOADP();
        const bf16* AB = (const bf16*)(p.ws + WS_AB); const bf16* X1 = (const bf16*)(p.ws + WS_X1);
        { SEpiRes<false> E{&p, X1 + (size_t)MP * D, 5}; skinny_gemm<8>(F, AB + (size_t)MP * DFF, (const bf16*)(p.ws + WS_W4T), D, DFF, (unsigned*)p.ws + CW_SK + 3 * 1024, p.ws, WS_SPART, E); }
        pg8::Gemm g{AB, (const bf16*)(p.ws + WS_W4T), MP, D, DFF}; pg8::StaticOrder S; S.init(MP, D, F.G, F.bid);
        pg8::EpiRes<false> E{X1, modp(p, 0, 5), (bf16*)(p.ws + WS_T)};
        pg8::gemm_phase<pg8::EpiRes<false>, pg8::StaticOrder, false, true>(F.lds + RING_OFF, g, S, E, F.tid);
        if (BOTH(8)) xcd_barrier(bar, F.tid);
    }
    if (IN(9)) { LOADP(); phase_l2(p, F); }
#undef IN
#undef BOTH
}
extern "C" void kernel_launch(void* const* d_in, const int* in_sizes, int n_in, void* d_out, int out_size, void* d_ws, size_t ws_size, hipStream_t stream) {
    static int grid = 0;
    if (grid == 0) {
        if (n_in != 31 || out_size != (int)O_END || ws_size < WS_END) { fprintf(stderr, "kernel_launch: unexpected shapes\n"); grid = -1; return; }
        int dev = 0, cus = 0;
        if (hipGetDevice(&dev) != hipSuccess || hipDeviceGetAttribute(&cus, hipDeviceAttributeMultiprocessorCount, dev) != hipSuccess) { grid = -1; return; }
        if (hipFuncSetAttribute((const void*)mega, hipFuncAttributeMaxDynamicSharedMemorySize, LDS_BYTES) != hipSuccess) { fprintf(stderr, "kernel_launch: hipFuncSetAttribute failed\n"); grid = -1; return; }
        int per_cu = 0; (void)hipOccupancyMaxActiveBlocksPerMultiprocessor(&per_cu, (const void*)mega, NWAVES * 64, LDS_BYTES); (void)hipGetLastError();
        if (cus != 256) fprintf(stderr, "kernel_launch: the phase programme is dealt for 256 CUs (device reports %d)\n", cus);
        grid = 256;
    }
    if (grid < 0) return;
    P p{};
    p.xp = (const float*)d_in[0]; p.xs = (const float*)d_in[1]; p.cp = (const float*)d_in[2]; p.cs = (const float*)d_in[3];
    p.ck = (const float*)d_in[4]; p.cv = (const float*)d_in[5]; p.clf = (const float*)d_in[6]; p.sre = (const float*)d_in[7]; p.sim = (const float*)d_in[8];
    p.pt = (const int*)d_in[9]; p.w_ada = (const float*)d_in[10]; p.b_ada = (const float*)d_in[11]; p.w_in = (const float*)d_in[12]; p.b_f = (const float*)d_in[13];
    p.w_o = (const float*)d_in[14]; p.a_re = (const float*)d_in[15]; p.a_im = (const float*)d_in[16]; p.log_dt = (const float*)d_in[17];
    p.b_re = (const float*)d_in[18]; p.b_im = (const float*)d_in[19]; p.c_re = (const float*)d_in[20]; p.c_im = (const float*)d_in[21];
    p.d_skip = (const float*)d_in[22]; p.w_glu = (const float*)d_in[23]; p.b_glu = (const float*)d_in[24]; p.ln1_g = (const float*)d_in[25]; p.ln1_b = (const float*)d_in[26];
    p.w_up = (const float*)d_in[27]; p.w_down = (const float*)d_in[28]; p.ln2_g = (const float*)d_in[29]; p.ln2_b = (const float*)d_in[30];
    p.out = (float*)d_out; p.ws = (unsigned char*)d_ws;
    (void)hipMemsetAsync((char*)d_ws + WS_CTL, 0, CTL_ZERO_BYTES, stream);
    p.ph_lo = 0; p.ph_hi = 10; p.li = 0; p.pad = 0;
    hipLaunchKernelGGL(mega, dim3(grid), dim3(NWAVES * 64), LDS_BYTES, stream, p);
    (void)in_sizes;
}
```
